# Optimizing an MI355X kernel written in HIP

```python
import math
import jax
import jax.numpy as jnp
from jax import lax
import numpy as np

D_MODEL = 1024
BATCH = 2
SEQ = 8192
DEPTH = 4

GRID_W = 64
CTX_LEN = 256
HEAD_DIM = 64
NA_HEADS = 6
NA_WIN_R = 8
NA_WIN_C = 16
SG_GROUPS = 4
SG_CHUNK = 128
GQA_Q_HEADS = 6
GQA_KV_HEADS = 2
Q_BLOCK = 128
ROPE_THETA = 10000.0

D_A = NA_HEADS * HEAD_DIM
D_B = SG_GROUPS * HEAD_DIM
D_C = GQA_Q_HEADS * HEAD_DIM
D_MIX = D_A + D_B + D_C
D_KV_C = GQA_KV_HEADS * HEAD_DIM
IN_SIZES = (D_A, D_A, D_A, 2 * D_B, D_C, D_KV_C, D_KV_C)
D_IN = 3 * D_A + 2 * D_B + D_C + 2 * D_KV_C
D_FF = int(math.ceil(8 * D_MODEL / 3 / 256)) * 256
N_MOD = 6
ALPHA = (2 * DEPTH) ** 0.25
BETA = (8 * DEPTH) ** -0.25
LN_EPS = 1e-6

kernel_name = "hybrid_na_sgmlp_gqa_deepnorm_prefix"


def layer_norm(x):
    xf = x.astype(jnp.float32)
    mu = jnp.mean(xf, -1, keepdims=True)
    var = jnp.mean(jnp.square(xf - mu), -1, keepdims=True)
    return ((xf - mu) * lax.rsqrt(var + LN_EPS)).astype(x.dtype)


def rms_norm(x, g):
    xf = x.astype(jnp.float32)
    y = xf * lax.rsqrt(jnp.mean(xf * xf, -1, keepdims=True) + LN_EPS)
    return y.astype(x.dtype) * g


def modulate(x, shift, scale):
    return layer_norm(x) * (1 + scale) + shift


def split_cols(p, sizes):
    out, off = [], 0
    for s in sizes:
        out.append(p[..., off:off + s])
        off += s
    return out


def heads(t, n):
    return t.reshape(t.shape[0], t.shape[1], n, HEAD_DIM)


def axial_rope_tables(n_tokens, dtype):
    t = jnp.arange(n_tokens, dtype=jnp.int32)
    row = (t // GRID_W).astype(jnp.float32)
    col = (t % GRID_W).astype(jnp.float32)
    n_freq = HEAD_DIM // 4
    inv = 1.0 / (ROPE_THETA ** (jnp.arange(n_freq, dtype=jnp.float32) / n_freq))
    ang = jnp.stack([row[:, None] * inv, col[:, None] * inv], axis=1)
    return jnp.cos(ang).astype(dtype), jnp.sin(ang).astype(dtype)


def apply_axial_rope(x, cos, sin):
    n_freq = HEAD_DIM // 4
    xr = x.reshape(*x.shape[:-1], 2, 2, n_freq)
    x1, x2 = xr[..., 0, :], xr[..., 1, :]
    c, s = cos[:, None], sin[:, None]
    out = jnp.stack([x1 * c - x2 * s, x2 * c + x1 * s], axis=-2)
    return out.reshape(x.shape)


def attend(q, k, v):
    scale = q.shape[-1] ** -0.5
    s = jnp.einsum('bqkgd,bskd->bkgqs', q, k) * scale
    p = jax.nn.softmax(s.astype(jnp.float32), axis=-1).astype(v.dtype)
    return jnp.einsum('bkgqs,bskd->bqkgd', p, v)


def neighbourhood_attention(q, k, v, k_ctx, v_ctx, rpb):
    B, S, H, Dh = q.shape
    rows = S // GRID_W
    kr = min(NA_WIN_R, rows)
    kcw = NA_WIN_C
    scale = Dh ** -0.5
    qg = q.reshape(B, rows, GRID_W, H, Dh)
    kg = k.reshape(B, rows, GRID_W, H, Dh)
    vg = v.reshape(B, rows, GRID_W, H, Dh)
    r_idx = jnp.arange(rows, dtype=jnp.int32)
    row_start = jnp.clip(r_idx - kr // 2, 0, rows - kr)
    c_idx = jnp.arange(GRID_W, dtype=jnp.int32)
    col_start = jnp.clip(c_idx - kcw // 2, 0, GRID_W - kcw)
    col_win = col_start[:, None] + jnp.arange(kcw, dtype=jnp.int32)[None, :]
    dc = col_win - c_idx[:, None] + (NA_WIN_C - 1)
    n_loc = kr * kcw

    def one_row(args):
        q_row, rs, r = args
        k_rows = lax.dynamic_slice_in_dim(kg, rs, kr, axis=1)
        v_rows = lax.dynamic_slice_in_dim(vg, rs, kr, axis=1)
        k_win = k_rows[:, :, col_win]
        v_win = v_rows[:, :, col_win]
        s_loc = jnp.einsum('bqhd,brqchd->bhqrc', q_row, k_win) * scale
        dr = rs + jnp.arange(kr, dtype=jnp.int32) - r + (NA_WIN_R - 1)
        bias = rpb[:, dr][:, :, dc]
        s_loc = s_loc + jnp.transpose(bias, (0, 2, 1, 3))[None]
        s_ctx = jnp.einsum('bqhd,blhd->bhql', q_row, k_ctx) * scale
        s = jnp.concatenate([s_loc.reshape(B, H, GRID_W, n_loc), s_ctx], axis=-1)
        p = jax.nn.softmax(s.astype(jnp.float32), axis=-1).astype(v.dtype)
        p_loc = p[..., :n_loc].reshape(B, H, GRID_W, kr, kcw)
        p_ctx = p[..., n_loc:]
        return (jnp.einsum('bhqrc,brqchd->bqhd', p_loc, v_win)
                + jnp.einsum('bhql,blhd->bqhd', p_ctx, v_ctx))

    out = lax.map(one_row, (jnp.transpose(qg, (1, 0, 2, 3, 4)), row_start, r_idx))
    return jnp.transpose(out, (1, 0, 2, 3, 4)).reshape(B, S, H, Dh)


def gqa_latent(q, k, v, k_ctx, v_ctx):
    B, S, Hq, Dh = q.shape
    G = Hq // GQA_KV_HEADS
    nb = S // Q_BLOCK
    qb = jnp.transpose(q.reshape(B, nb, Q_BLOCK, GQA_KV_HEADS, G, Dh), (1, 0, 2, 3, 4, 5))
    k_all = jnp.concatenate([k, k_ctx], axis=1)
    v_all = jnp.concatenate([v, v_ctx], axis=1)
    out = lax.map(lambda qblk: attend(qblk, k_all, v_all), qb)
    return jnp.transpose(out, (1, 0, 2, 3, 4, 5)).reshape(B, S, Hq, Dh)


def spatial_gating(z, w_s, b_s, g_sgu):
    B, N, _ = z.shape
    u, v = z[..., :D_B], z[..., D_B:]
    v = layer_norm(v) * g_sgu
    vc = v.reshape(B, N // SG_CHUNK, SG_CHUNK, SG_GROUPS, HEAD_DIM)
    mixed = jnp.einsum('gpq,bnqgc->bnpgc', w_s, vc) + jnp.transpose(b_s)[None, None, :, :, None]
    return u * mixed.reshape(B, N, D_B)


def merge_groups(o_a, o_b, o_c, g_out):
    B, N = o_b.shape[0], o_b.shape[1]
    return jnp.concatenate([
        rms_norm(o_a.reshape(B, N, D_A), g_out[:D_A]),
        rms_norm(o_b, g_out[D_A:D_A + D_B]),
        rms_norm(o_c.reshape(B, N, D_C), g_out[D_A + D_B:]),
    ], axis=-1)


def mixing_sublayer(h, hc, w_in, rpb, w_s, b_s, g_sgu, g_q, g_k, g_out, w_o, need_ctx_out):
    B, S, _ = h.shape
    qa, ka, va, zb, qc, kc, vc = split_cols(h @ w_in, IN_SIZES)
    qa_x, ka_x, va_x, zb_x, qc_x, kc_x, vc_x = split_cols(hc @ w_in, IN_SIZES)
    cos, sin = axial_rope_tables(S, h.dtype)
    ka_x, va_x = heads(ka_x, NA_HEADS), heads(va_x, NA_HEADS)
    kc_x = rms_norm(heads(kc_x, GQA_KV_HEADS), g_k)
    vc_x = heads(vc_x, GQA_KV_HEADS)
    o_a = neighbourhood_attention(heads(qa, NA_HEADS), heads(ka, NA_HEADS), heads(va, NA_HEADS),
                                  ka_x, va_x, rpb)
    o_b = spatial_gating(jax.nn.gelu(zb), w_s, b_s, g_sgu)
    q_c = apply_axial_rope(rms_norm(heads(qc, GQA_Q_HEADS), g_q), cos, sin)
    k_c = apply_axial_rope(rms_norm(heads(kc, GQA_KV_HEADS), g_k), cos, sin)
    o_c = gqa_latent(q_c, k_c, heads(vc, GQA_KV_HEADS), kc_x, vc_x)
    y = merge_groups(o_a, o_b, o_c, g_out) @ w_o
    if not need_ctx_out:
        return y, None
    L = hc.shape[1]
    o_ax = attend(heads(qa_x, NA_HEADS)[:, :, :, None], ka_x, va_x)
    o_bx = spatial_gating(jax.nn.gelu(zb_x), w_s, b_s, g_sgu)
    q_cx = rms_norm(heads(qc_x, GQA_Q_HEADS), g_q).reshape(
        B, L, GQA_KV_HEADS, GQA_Q_HEADS // GQA_KV_HEADS, HEAD_DIM)
    o_cx = attend(q_cx, kc_x, vc_x)
    yc = merge_groups(o_ax, o_bx, o_cx, g_out) @ w_o
    return y, yc


def swiglu(h, w_in, w_out):
    a, b = h @ w_in[:, :D_FF], h @ w_in[:, D_FF:]
    return (jax.nn.silu(a) * b) @ w_out


def setup_inputs(seed: int = 0) -> dict:
    key = jax.random.key(seed)
    ks = jax.random.split(key, 24)
    n = jax.random.normal
    f = jnp.float32
    return {
        "x": n(ks[0], (BATCH, SEQ, D_MODEL), f),
        "c": n(ks[1], (BATCH, D_MODEL), f),
        "ctx": n(ks[2], (BATCH, CTX_LEN, D_MODEL), f),
        "c_ctx": n(ks[3], (D_MODEL,), f),
        "w_mod": n(ks[4], (DEPTH, D_MODEL, N_MOD * D_MODEL), f) * (0.5 * D_MODEL ** -0.5),
        "b_mod": n(ks[5], (DEPTH, N_MOD * D_MODEL), f) * 0.02,
        "w_in": n(ks[6], (DEPTH, D_MODEL, D_IN), f) * D_MODEL ** -0.5,
        "rpb": n(ks[7], (DEPTH, NA_HEADS, 2 * NA_WIN_R - 1, 2 * NA_WIN_C - 1), f) * 0.02,
        "w_s": n(ks[8], (DEPTH, SG_GROUPS, SG_CHUNK, SG_CHUNK), f) * SG_CHUNK ** -0.5,
        "b_s": n(ks[9], (DEPTH, SG_GROUPS, SG_CHUNK), f) * 0.02,
        "g_sgu": 1.0 + 0.02 * n(ks[10], (DEPTH, D_B), f),
        "g_q": 1.0 + 0.02 * n(ks[11], (DEPTH, HEAD_DIM), f),
        "g_k": 1.0 + 0.02 * n(ks[12], (DEPTH, HEAD_DIM), f),
        "g_out": 1.0 + 0.02 * n(ks[13], (DEPTH, D_MIX), f),
        "w_o": n(ks[14], (DEPTH, D_MIX, D_MODEL), f) * (D_MIX ** -0.5 * BETA),
        "ln1_g": 1.0 + 0.02 * n(ks[15], (DEPTH, D_MODEL), f),
        "ln1_b": 0.02 * n(ks[16], (DEPTH, D_MODEL), f),
        "w_ffn_in": n(ks[17], (DEPTH, D_MODEL, 2 * D_FF), f) * D_MODEL ** -0.5,
        "w_ffn_out": n(ks[18], (DEPTH, D_FF, D_MODEL), f) * (D_FF ** -0.5 * BETA),
        "ln2_g": 1.0 + 0.02 * n(ks[19], (DEPTH, D_MODEL), f),
        "ln2_b": 0.02 * n(ks[20], (DEPTH, D_MODEL), f),
    }


def reference(x, c, ctx, c_ctx, w_mod, b_mod, w_in, rpb, w_s, b_s, g_sgu, g_q, g_k, g_out, w_o,
              ln1_g, ln1_b, w_ffn_in, w_ffn_out, ln2_g, ln2_b):
    sc = jax.nn.silu(c)
    sc_ctx = jax.nn.silu(c_ctx)
    for l in range(DEPTH):
        need_ctx_out = l < DEPTH - 1
        mod = split_cols((sc @ w_mod[l] + b_mod[l])[:, None, :], (D_MODEL,) * N_MOD)
        mod_x = split_cols(sc_ctx @ w_mod[l] + b_mod[l], (D_MODEL,) * N_MOD)
        sh1, sc1, g1, sh2, sc2, g2 = mod
        sh1x, sc1x, g1x, sh2x, sc2x, g2x = mod_x
        h = modulate(x, sh1, sc1)
        hc = modulate(ctx, sh1x, sc1x)
        y, yc = mixing_sublayer(h, hc, w_in[l], rpb[l], w_s[l], b_s[l], g_sgu[l], g_q[l], g_k[l],
                                g_out[l], w_o[l], need_ctx_out)
        x = layer_norm(ALPHA * x + g1 * y) * ln1_g[l] + ln1_b[l]
        x = layer_norm(ALPHA * x + g2 * swiglu(modulate(x, sh2, sc2), w_ffn_in[l], w_ffn_out[l])) \
            * ln2_g[l] + ln2_b[l]
        if need_ctx_out:
            ctx = layer_norm(ALPHA * ctx + g1x * yc) * ln1_g[l] + ln1_b[l]
            ctx = layer_norm(ALPHA * ctx + g2x * swiglu(modulate(ctx, sh2x, sc2x), w_ffn_in[l],
                                                         w_ffn_out[l])) * ln2_g[l] + ln2_b[l]
    return x
```

```cpp
#include <hip/hip_runtime.h>
#include <hip/hip_cooperative_groups.h>
#include <cstdio>
#include <cstdint>
#include <cmath>
namespace cg = cooperative_groups;

#define LAS __attribute__((address_space(3)))
typedef unsigned short bf16_t;
typedef short bf16x8 __attribute__((ext_vector_type(8)));
typedef float f32x4 __attribute__((ext_vector_type(4)));
typedef float f32x2 __attribute__((ext_vector_type(2)));
typedef float f32x16 __attribute__((ext_vector_type(16)));
typedef unsigned u32x4 __attribute__((ext_vector_type(4)));
typedef unsigned u32x2 __attribute__((ext_vector_type(2)));
typedef short s16x4 __attribute__((ext_vector_type(4)));

constexpr int DM = 1024, BATCH = 2, SEQ = 8192, DEPTH = 4, CTXL = 256;
constexpr int RPB = SEQ + CTXL;
constexpr int MROWS = BATCH * RPB;
constexpr int DIN = 2304, DFF = 2816, NMOD = 6 * DM;
constexpr int C_QC = 0, C_KC = 384, C_U = 512, C_V = 768, C_QA = 1024, C_KA = 1408, C_VA = 1792, C_VC = 2176;
constexpr float LN_EPS = 1e-6f;
constexpr float ALPHA = 1.681792830507429f;
constexpr float LOG2E = 1.4426950408889634f;
constexpr float C2 = 0.125f * LOG2E;

__device__ __forceinline__ unsigned char* opq(unsigned char* p) { asm volatile("" : "+s"(p)); return p; }
__device__ __forceinline__ int opaque_tid() { int t; asm volatile("v_mov_b32 %0, %1" : "=v"(t) : "v"((int)threadIdx.x)); return t; }
__device__ __forceinline__ unsigned cvt_pk_bf16(float lo, float hi) { unsigned r; asm volatile("v_cvt_pk_bf16_f32 %0, %1, %2" : "=v"(r) : "v"(lo), "v"(hi)); return r; }
__device__ __forceinline__ float bf2f(unsigned short h) { return __uint_as_float(((unsigned)h) << 16); }
__device__ __forceinline__ float wave_sum(float v) {
#pragma unroll
    for (int o = 1; o < 64; o <<= 1) v += __shfl_xor(v, o);
    return v;
}

__constant__ short qkv_order_tab[594] = {39, 111, 184, 256, 328, 400, 472, 558, 40, 112, 185, 257, 329, 401, 473, 559, 41, 113, 186, 258, 330, 402, 474, 560, 42, 114, 187, 259, 331, 403, 475, 561, 43, 115, 188, 260, 332, 404, 476, 562, 44, 116, 189, 261, 333, 405, 477, 563, 45, 117, 190, 262, 334, 406, 478, 564, 46, 118, 191, 263, 335, 407, 479, 565, 47, 119, 192, 264, 336, 408, 480, 566, 48, 120, 193, 265, 337, 409, 481, 567, 49, 121, 194, 266, 338, 410, 482, 568, 0, 75, 150, 224, 298, 372, 446, 576, 1, 76, 151, 225, 299, 373, 447, 577, 2, 77, 152, 226, 300, 374, 504, 578, 3, 78, 153, 227, 301, 375, 505, 579, 4, 79, 154, 228, 302, 432, 506, 520, 5, 80, 155, 229, 303, 433, 507, 521, 6, 81, 156, 230, 360, 434, 508, 522, 7, 82, 157, 231, 361, 435, 509, 523, 8, 83, 158, 288, 362, 436, 510, 524, 9, 84, 159, 289, 363, 437, 511, 525, 10, 85, 216, 290, 364, 438, 512, 526, 11, 86, 217, 291, 365, 439, 513, 527, 12, 87, 218, 292, 366, 440, 514, 528, 13, 144, 219, 293, 367, 441, 515, 529, 14, 145, 220, 294, 368, 442, 516, 530, 15, 146, 221, 295, 369, 443, 517, 531, 72, 147, 222, 296, 370, 444, 518, 532, 73, 148, 223, 297, 371, 445, 519, 533, 74, 149, 160, 232, 304, 376, 448, 534, 16, 88, 161, 233, 305, 377, 449, 535, 17, 89, 162, 234, 306, 378, 450, 536, 50, 122, 195, 267, 339, 411, 483, 569, 51, 123, 196, 268, 340, 412, 484, 570, 52, 124, 197, 269, 341, 413, 485, 571, 53, 125, 198, 270, 342, 414, 486, 572, 54, 126, 199, 271, 343, 415, 487, 573, 55, 127, 200, 272, 344, 416, 488, 574, 56, 128, 201, 273, 345, 417, 489, 575, 57, 129, 202, 274, 346, 418, 490, 580, 58, 130, 203, 275, 347, 419, 491, 581, 59, 131, 204, 276, 348, 420, 492, 582, 60, 132, 205, 277, 349, 421, 493, 583, 18, 90, 163, 235, 307, 379, 451, 537, 19, 91, 164, 236, 308, 380, 452, 538, 20, 92, 165, 237, 309, 381, 453, 539, 21, 93, 166, 238, 310, 382, 454, 540, 22, 94, 167, 239, 311, 383, 455, 541, 23, 95, 168, 240, 312, 384, 456, 542, 24, 96, 169, 241, 313, 385, 457, 543, 25, 97, 170, 242, 314, 386, 458, 544, 26, 98, 171, 243, 315, 387, 459, 545, 27, 99, 172, 244, 316, 388, 460, 546, 28, 100, 173, 245, 317, 389, 461, 547, 29, 101, 174, 246, 318, 390, 462, 548, 30, 102, 175, 247, 319, 391, 463, 549, 31, 103, 176, 248, 320, 392, 464, 550, 32, 104, 177, 249, 321, 393, 465, 551, 33, 105, 178, 250, 322, 394, 466, 552, 34, 106, 179, 251, 323, 395, 467, 553, 35, 107, 180, 252, 324, 396, 468, 554, 36, 108, 181, 253, 325, 397, 469, 555, 37, 109, 182, 254, 326, 398, 470, 556, 38, 110, 183, 255, 327, 399, 471, 557, 61, 133, 206, 278, 350, 422, 494, 584, 62, 134, 207, 279, 351, 423, 495, 585, 63, 135, 208, 280, 352, 424, 496, 586, 64, 136, 209, 281, 353, 425, 497, 587, 65, 137, 210, 282, 354, 426, 498, 588, 66, 138, 211, 283, 355, 427, 499, 589, 67, 139, 212, 284, 356, 428, 500, 590, 68, 140, 213, 285, 357, 429, 501, 591, 69, 141, 214, 286, 358, 430, 502, 592, 70, 142, 215, 287, 359, 431, 503, 593, 71, 143};
namespace pg8 {
constexpr int BM = 256, BK = 64, HALF = 128, HTB = HALF * BK * 2, STAGE_BYTES = 8 * HTB, NXCD = 8, WGM = 8;
__host__ __device__ __forceinline__ int lds_byte(int r, int c) { const int st = (r >> 4) * 2 + (c >> 5), rr = r & 15, cc = c & 31, ob = rr * 64 + cc * 2; return st * 1024 + (ob ^ (((ob >> 9) & 1) << 5)); }
__host__ __device__ __forceinline__ void stage_rc(int b, int& R, int& C) { const int st = b / 1024, sb = b % 1024, swz = sb ^ (((sb >> 9) & 1) << 5); R = (st >> 1) * 16 + swz / 64; C = (st & 1) * 32 + (swz % 64) / 2; }
__host__ __device__ __forceinline__ int perm32(int rho) { const int n = rho >> 4, i = rho & 15; return 8 * (i >> 2) + 4 * n + (i & 3); }

struct Unit { int pm, pn, kt0, nt; };
struct Gemm { const bf16_t* A; const bf16_t* Bt; int M, N, K; };

struct StaticOrder {
    int nM, nN, nwg, G, c, skipctx, ntK, xmode;
    __host__ __device__ void init(int nM_, int N, int G_, int c_, int skipctx_, int ntK_, int xmode_ = 0) { nM = nM_; nN = N / BM; nwg = nM * nN; G = G_; c = c_; skipctx = skipctx_; ntK = ntK_; xmode = xmode_; }
    __host__ __device__ bool next(int i, Unit& u) const {
        const long L = (long)i * G + c;
        if (L >= nwg) {
            if (xmode == 0 || xmode == 4) return false;
            const int rounds = (nwg + G - 1) / G; const int j = (int)((long)(i - rounds) * G + c);
            const int per = (xmode == 1) ? 3 : 11;
            if (i < rounds || j < 0 || j >= 8 * per) return false;
            const int tile = j / per, sl = j % per; u.pm = (tile >> 2) ? 65 : 32; u.pn = tile & 3;
            if (xmode == 1) { u.kt0 = (sl == 0) ? 0 : (sl == 1 ? 6 : 10); u.nt = (sl == 1) ? 4 : 6; } else { u.kt0 = 4 * sl; u.nt = 4; }
            return true;
        }
        int wgid = (int)L; { const int q = nwg / NXCD, r = nwg % NXCD, xcd = wgid % NXCD, off = wgid / NXCD; wgid = (xcd < r ? xcd * (q + 1) : r * (q + 1) + (xcd - r) * q) + off; }
#if defined(__HIP_DEVICE_COMPILE__)
        if (xmode == 4) wgid = qkv_order_tab[L];
#endif
        const int nig = WGM * nN, gid = wgid / nig, fm = gid * WGM, gsz = (nM - fm) < WGM ? (nM - fm) : WGM;
        u.pm = fm + ((wgid % nig) % gsz); u.pn = (wgid % nig) / gsz; u.kt0 = 0; u.nt = ntK;
        if (skipctx) u.pm += (u.pm >= 32) ? 1 : 0;
        return true;
    }
};

__device__ __forceinline__ float gelu_tanh(float v) {
    const float u = 0.7978845608028654f * (v + 0.044715f * v * v * v);
    return v * __builtin_amdgcn_rcpf(1.0f + __builtin_amdgcn_exp2f(-2.0f * LOG2E * u));
}
__device__ __forceinline__ float silu_f(float v) { return v * __builtin_amdgcn_rcpf(1.0f + __builtin_amdgcn_exp2f(-LOG2E * v)); }

struct EpiQKV {
    static constexpr bool PERM = true, AFTER_DRAIN = false, KSEG = false;
    bf16_t* O; const float* gq; const float* gk; const float* tcos; const float* tsin;
    __device__ __forceinline__ void kseg(f32x4 (&)[2][2][4][2], const Unit&, int, int, int) const {}
    __device__ __forceinline__ void operator()(const f32x4 (&acc)[2][2][4][2], const Unit& u, int wr, int wc, int fr, int fq) const {
        const int row0 = u.pm * BM + wr * 64 + fr;
        if (u.pn < 2) {
            const int head = 4 * u.pn + wc; const bool isq = head < 6;
            const float* g = isq ? gq : gk; const float gs = isq ? C2 : 1.0f;
            f32x4 gv[2][2];
#pragma unroll
            for (int bj = 0; bj < 2; ++bj)
#pragma unroll
                for (int n = 0; n < 2; ++n) gv[bj][n] = *(const f32x4*)(g + 32 * bj + 8 * fq + 4 * n) * gs;
            const int ocol = 64 * head + 8 * fq;
#pragma unroll
            for (int ai = 0; ai < 2; ++ai)
#pragma unroll
                for (int m = 0; m < 4; ++m) {
                    const int row = row0 + ai * HALF + m * 16;
                    const int w = row >= RPB ? row - RPB : row;
                    f32x4 x[2][2]; float ss = 0.f;
#pragma unroll
                    for (int bj = 0; bj < 2; ++bj)
#pragma unroll
                        for (int n = 0; n < 2; ++n) { x[bj][n] = acc[ai][bj][m][n]; const f32x4 q = x[bj][n] * x[bj][n]; ss += (q[0] + q[1]) + (q[2] + q[3]); }
                    ss += __shfl_xor(ss, 16); ss += __shfl_xor(ss, 32);
                    const float rinv = 1.0f / sqrtf(ss * (1.0f / 64.0f) + LN_EPS);
#pragma unroll
                    for (int bj = 0; bj < 2; ++bj)
#pragma unroll
                        for (int n = 0; n < 2; ++n) x[bj][n] = x[bj][n] * rinv * gv[bj][n];
                    if (w < SEQ) {
#pragma unroll
                        for (int bj = 0; bj < 2; ++bj) {
                            const int pos = bj ? (w & 63) : (w >> 6);
#pragma unroll
                            for (int n = 0; n < 2; ++n) {
                                const f32x4 cs = *(const f32x4*)(tcos + pos * 16 + 8 * (fq & 1) + 4 * n);
                                const f32x4 sn = *(const f32x4*)(tsin + pos * 16 + 8 * (fq & 1) + 4 * n);
                                f32x4 p; p[0] = __shfl_xor(x[bj][n][0], 32); p[1] = __shfl_xor(x[bj][n][1], 32); p[2] = __shfl_xor(x[bj][n][2], 32); p[3] = __shfl_xor(x[bj][n][3], 32);
                                const f32x4 sgn = (fq < 2) ? -sn : sn;
                                x[bj][n] = x[bj][n] * cs + p * sgn;
                            }
                        }
                    }
                    bf16_t* rowp = O + (size_t)row * DIN + ocol;
#pragma unroll
                    for (int bj = 0; bj < 2; ++bj) { u32x4 wv; wv.x = cvt_pk_bf16(x[bj][0][0], x[bj][0][1]); wv.y = cvt_pk_bf16(x[bj][0][2], x[bj][0][3]); wv.z = cvt_pk_bf16(x[bj][1][0], x[bj][1][1]); wv.w = cvt_pk_bf16(x[bj][1][2], x[bj][1][3]);
                        *(u32x4*)(rowp + 32 * bj) = wv; }
                }
        } else {
            const bool isg = u.pn < 4;
            const int col0 = u.pn * BM + wc * 32 + 8 * fq;
#pragma unroll
            for (int ai = 0; ai < 2; ++ai)
#pragma unroll
                for (int m = 0; m < 4; ++m) { bf16_t* rowp = O + (size_t)(row0 + ai * HALF + m * 16) * DIN + col0;
#pragma unroll
                    for (int bj = 0; bj < 2; ++bj) { f32x4 v0 = acc[ai][bj][m][0], v1 = acc[ai][bj][m][1];
                        if (isg) {
#pragma unroll
                            for (int j = 0; j < 4; ++j) { v0[j] = gelu_tanh(v0[j]); v1[j] = gelu_tanh(v1[j]); }
                        } else { const float sc = (u.pn * BM + bj * HALF < C_KA) ? C2 : 1.0f; v0 = v0 * sc; v1 = v1 * sc; }
                        u32x4 wv; wv.x = cvt_pk_bf16(v0[0], v0[1]); wv.y = cvt_pk_bf16(v0[2], v0[3]); wv.z = cvt_pk_bf16(v1[0], v1[1]); wv.w = cvt_pk_bf16(v1[2], v1[3]);
                        *(u32x4*)(rowp + bj * HALF) = wv; } }
        }
    }
};

struct EpiSwiGLU {
    static constexpr bool PERM = true, AFTER_DRAIN = false, KSEG = false;
    bf16_t* O;
    __device__ __forceinline__ void kseg(f32x4 (&)[2][2][4][2], const Unit&, int, int, int) const {}
    __device__ __forceinline__ void operator()(const f32x4 (&acc)[2][2][4][2], const Unit& u, int wr, int wc, int fr, int fq) const {
        const int row0 = u.pm * BM + wr * 64 + fr; const int col0 = u.pn * HALF + wc * 32 + 8 * fq;
#pragma unroll
        for (int ai = 0; ai < 2; ++ai)
#pragma unroll
            for (int m = 0; m < 4; ++m) { bf16_t* rowp = O + (size_t)(row0 + ai * HALF + m * 16) * DFF + col0;
                f32x4 v0, v1;
#pragma unroll
                for (int j = 0; j < 4; ++j) { v0[j] = silu_f(acc[ai][0][m][0][j]) * acc[ai][1][m][0][j]; v1[j] = silu_f(acc[ai][0][m][1][j]) * acc[ai][1][m][1][j]; }
                u32x4 wv; wv.x = cvt_pk_bf16(v0[0], v0[1]); wv.y = cvt_pk_bf16(v0[2], v0[3]); wv.z = cvt_pk_bf16(v1[0], v1[1]); wv.w = cvt_pk_bf16(v1[2], v1[3]);
                *(u32x4*)rowp = wv; }
    }
};

template <bool SEG> struct EpiY {
    static constexpr bool PERM = true, AFTER_DRAIN = false, KSEG = SEG;
    bf16_t* O; const float* ss; float* y32; int ntfull; const LAS float* ftab = nullptr;
    __device__ __forceinline__ void kseg(f32x4 (&acc)[2][2][4][2], const Unit& u, int t, int wr, int fr) const {
        if (ftab) {
#pragma unroll
            for (int ai = 0; ai < 2; ++ai)
#pragma unroll
                for (int m = 0; m < 4; ++m) { const float f = ftab[(ai * HALF + wr * 64 + m * 16 + fr) * 4 + (t == 6 ? 0 : 1)];
#pragma unroll
                    for (int bj = 0; bj < 2; ++bj)
#pragma unroll
                        for (int n = 0; n < 2; ++n) acc[ai][bj][m][n] = acc[ai][bj][m][n] * f; }
            return;
        }
        const float* sp = ss + (size_t)(u.pm * BM + wr * 64 + fr) * 4 + (t == 6 ? 0 : 1);
        const float n0 = (t == 6) ? (1.0f / 384.0f) : (1.0f / 256.0f), n1 = (t == 6) ? (1.0f / 256.0f) : (1.0f / 384.0f);
#pragma unroll
        for (int ai = 0; ai < 2; ++ai)
#pragma unroll
            for (int m = 0; m < 4; ++m) { const float* q = sp + (size_t)(ai * HALF + m * 16) * 4; const float s0 = q[0], s1 = q[1];
                const float f = sqrtf((s1 * n1 + LN_EPS) / (s0 * n0 + LN_EPS));
#pragma unroll
                for (int bj = 0; bj < 2; ++bj)
#pragma unroll
                    for (int n = 0; n < 2; ++n) acc[ai][bj][m][n] = acc[ai][bj][m][n] * f;
                asm volatile("" ::: "memory"); }
    }
    __device__ __forceinline__ void operator()(const f32x4 (&acc)[2][2][4][2], const Unit& u, int wr, int wc, int fr, int fq) const {
        const int row0 = u.pm * BM + wr * 64 + fr; const int col0 = u.pn * BM + wc * 32 + 8 * fq;
        if (u.nt != ntfull) {
            const int seg = (u.kt0 == 0) ? 0 : (u.kt0 == 6 ? 1 : 2); const float nn = (seg == 1) ? (1.0f / 256.0f) : (1.0f / 384.0f);
            const int crow0 = (u.pm == 32 ? 0 : 256) + wr * 64 + fr; const int slice = SEG ? seg : (u.kt0 >> 2);
#pragma unroll
            for (int ai = 0; ai < 2; ++ai)
#pragma unroll
                for (int m = 0; m < 4; ++m) { const int row = row0 + ai * HALF + m * 16; float* yp = y32 + ((size_t)slice * 512 + crow0 + ai * HALF + m * 16) * DM + col0;
                    float sc = 1.0f; if (SEG) sc = 1.0f / sqrtf(ss[(size_t)row * 4 + seg] * nn + LN_EPS);
#pragma unroll
                    for (int bj = 0; bj < 2; ++bj)
#pragma unroll
                        for (int n = 0; n < 2; ++n) *(f32x4*)(yp + bj * HALF + 4 * n) = acc[ai][bj][m][n] * sc; }
            return;
        }
#pragma unroll
        for (int ai = 0; ai < 2; ++ai)
#pragma unroll
            for (int m = 0; m < 4; ++m) { const int row = row0 + ai * HALF + m * 16; bf16_t* rowp = O + (size_t)row * DM + col0;
                float sc = 1.0f; if (SEG) { if (ftab) sc = ftab[(ai * HALF + wr * 64 + m * 16 + fr) * 4 + 2];
                    else { const float s2 = ss[(size_t)row * 4 + 2]; sc = 1.0f / sqrtf(s2 * (1.0f / 384.0f) + LN_EPS); } }
#pragma unroll
                for (int bj = 0; bj < 2; ++bj) { const f32x4 v0 = acc[ai][bj][m][0] * sc, v1 = acc[ai][bj][m][1] * sc;
                    u32x4 wv; wv.x = cvt_pk_bf16(v0[0], v0[1]); wv.y = cvt_pk_bf16(v0[2], v0[3]); wv.z = cvt_pk_bf16(v1[0], v1[1]); wv.w = cvt_pk_bf16(v1[2], v1[3]);
                    *(u32x4*)(rowp + bj * HALF) = wv; } }
    }
};

template <class Epi, class Sched, bool ALIGN_EPI = false, bool SP2 = false>
__device__ __forceinline__ void gemm_phase(LAS unsigned char* lds, const Gemm g, const Sched& S, const Epi& E) {
    const int tid = opaque_tid(), wid = __builtin_amdgcn_readfirstlane(tid >> 6), lane = tid & 63, wr = wid >> 2, wc = wid & 3, fr = lane & 15, fq = lane >> 4;
    const int K = g.K;
    unsigned voffA[2], voffB[2];
#pragma unroll
    for (int i = 0; i < 2; ++i) { int R, C; stage_rc(tid * 16 + i * 8192, R, C); const int Rb = Epi::PERM ? ((R & ~31) + perm32(R & 31)) : R;
        voffA[i] = (unsigned)(R * K + C) * 2u; voffB[i] = (unsigned)(Rb * K + C) * 2u; }
    const size_t kstep = (size_t)(BK * 2);
    const size_t hstep = (size_t)HALF * K * 2;
    const size_t tstep = 2 * hstep;
    const unsigned ldsw = (unsigned)wid * 1024u;
    const int aoff = lds_byte(wr * 64 + fr, fq * 8), boff = lds_byte(wc * 32 + fr, fq * 8);
#define PG8_SA(b, h) (((b) * 2 + (h)) * HTB)
#define PG8_SB(b, h) ((4 + (b) * 2 + (h)) * HTB)
#define PG8_STAGE(bufoff, gbase, voff) do { _Pragma("unroll") for (int _i = 0; _i < 2; ++_i) \
        __builtin_amdgcn_global_load_lds((const unsigned*)((const char*)(gbase) + (voff)[_i]), (LAS unsigned*)(lds + (bufoff) + ldsw + _i * 8192), 16, 0, 0); } while (0)
#define PG8_LDA(dst, b, h) do { _Pragma("unroll") for (int m = 0; m < 4; ++m) _Pragma("unroll") for (int k = 0; k < 2; ++k) dst[m][k] = *(const LAS bf16x8*)(lds + PG8_SA(b, h) + aoff + m * 2048 + k * 1024); } while (0)
#define PG8_LDB(dst, b, h) do { _Pragma("unroll") for (int n = 0; n < 2; ++n) _Pragma("unroll") for (int k = 0; k < 2; ++k) dst[n][k] = *(const LAS bf16x8*)(lds + PG8_SB(b, h) + boff + n * 2048 + k * 1024); } while (0)
#define PG8_MMA(ai, bj, At, Bt) do { __builtin_amdgcn_s_setprio(1); _Pragma("unroll") for (int m = 0; m < 4; ++m) _Pragma("unroll") for (int n = 0; n < 2; ++n) _Pragma("unroll") for (int k = 0; k < 2; ++k) \
        acc[ai][bj][m][n] = __builtin_amdgcn_mfma_f32_16x16x32_bf16(Bt[n][k], At[m][k], acc[ai][bj][m][n], 0, 0, 0); __builtin_amdgcn_s_setprio(0); } while (0)
#define PG8_WAIT_V(n) asm volatile("s_waitcnt vmcnt(" #n ")" ::: "memory")
#define PG8_WAIT_L(n) asm volatile("s_waitcnt lgkmcnt(" #n ")" ::: "memory")
#define PG8_BAR __builtin_amdgcn_s_barrier()
#define PG8_SCHED __builtin_amdgcn_sched_barrier(0)
    Unit cur, nxt; int ui = 0;
    if (!S.next(0, cur)) return;
    f32x4 acc[2][2][4][2];
#pragma unroll
    for (int a = 0; a < 2; ++a)
#pragma unroll
        for (int b = 0; b < 2; ++b)
#pragma unroll
            for (int m = 0; m < 4; ++m)
#pragma unroll
                for (int n = 0; n < 2; ++n) acc[a][b][m][n] = (f32x4){0.f, 0.f, 0.f, 0.f};
    bf16x8 At[4][2], B0[2][2], B1[2][2];
    const char* cA = (const char*)g.A + (size_t)cur.pm * tstep + (size_t)cur.kt0 * kstep; const char* cB = (const char*)g.Bt + (size_t)cur.pn * tstep + (size_t)cur.kt0 * kstep;
    if constexpr (SP2) {
        PG8_STAGE(PG8_SB(0, 0), cB, voffB); PG8_STAGE(PG8_SB(0, 1), cB + hstep, voffB); PG8_STAGE(PG8_SA(0, 0), cA, voffA); PG8_STAGE(PG8_SA(0, 1), cA + hstep, voffA);
        if (wr == 1) PG8_BAR;
        PG8_WAIT_V(2); PG8_BAR;
        PG8_STAGE(PG8_SB(1, 0), cB + kstep, voffB); PG8_STAGE(PG8_SA(1, 0), cA + kstep, voffA); PG8_STAGE(PG8_SB(1, 1), cB + hstep + kstep, voffB);
        PG8_WAIT_V(6); PG8_BAR;
    } else {
        PG8_STAGE(PG8_SB(0, 0), cB, voffB); PG8_STAGE(PG8_SA(0, 0), cA, voffA); PG8_STAGE(PG8_SB(0, 1), cB + hstep, voffB); PG8_STAGE(PG8_SA(0, 1), cA + hstep, voffA);
        if (wr == 1) PG8_BAR;
        PG8_WAIT_V(4); PG8_BAR;
        PG8_STAGE(PG8_SB(1, 0), cB + kstep, voffB); PG8_STAGE(PG8_SA(1, 0), cA + kstep, voffA); PG8_STAGE(PG8_SB(1, 1), cB + hstep + kstep, voffB);
        PG8_WAIT_V(6); PG8_BAR;
    }
    for (;;) {
        const bool has_next = S.next(ui + 1, nxt);
        const char* nA = has_next ? (const char*)g.A + (size_t)nxt.pm * tstep + (size_t)nxt.kt0 * kstep : cA; const char* nB = has_next ? (const char*)g.Bt + (size_t)nxt.pn * tstep + (size_t)nxt.kt0 * kstep : cB;
        const int nt = cur.nt;
        for (int t = 0; t < nt; t += 2) {
            const bool last = (t == nt - 2);
            const char* a1 = cA + (size_t)(t + 1) * kstep;
            const char* a2 = last ? nA : cA + (size_t)(t + 2) * kstep; const char* b2 = last ? nB : cB + (size_t)(t + 2) * kstep;
            const char* a3 = a2 + kstep; const char* b3 = b2 + kstep;
            if constexpr (Epi::KSEG) { if ((t == 6 || t == 10) && nt == 16) { E.kseg(acc, cur, t, wr, fr); if (!E.ftab) PG8_WAIT_V(0); PG8_SCHED; } }
            if constexpr (SP2) {
            PG8_LDB(B0, 0, 0); PG8_LDB(B1, 0, 1); PG8_SCHED; PG8_LDA(At, 0, 0); PG8_STAGE(PG8_SA(1, 1), a1 + hstep, voffA);
            PG8_WAIT_V(8); PG8_WAIT_L(0); PG8_BAR; PG8_MMA(0, 0, At, B0); PG8_MMA(0, 1, At, B1); PG8_BAR; PG8_SCHED;
            PG8_LDA(At, 0, 1); PG8_STAGE(PG8_SB(0, 0), b2, voffB); PG8_STAGE(PG8_SB(0, 1), b2 + hstep, voffB); PG8_STAGE(PG8_SA(0, 0), a2, voffA);
            PG8_WAIT_V(8); PG8_WAIT_L(0); PG8_BAR; PG8_MMA(1, 0, At, B0); PG8_MMA(1, 1, At, B1); PG8_BAR; PG8_SCHED;
            PG8_LDB(B0, 1, 0); PG8_LDB(B1, 1, 1); PG8_SCHED; PG8_LDA(At, 1, 0); PG8_STAGE(PG8_SA(0, 1), a2 + hstep, voffA);
            PG8_WAIT_V(8); PG8_WAIT_L(0); PG8_BAR; PG8_MMA(0, 0, At, B0); PG8_MMA(0, 1, At, B1); PG8_BAR; PG8_SCHED;
            PG8_LDA(At, 1, 1); PG8_STAGE(PG8_SB(1, 0), b3, voffB); PG8_STAGE(PG8_SB(1, 1), b3 + hstep, voffB); PG8_STAGE(PG8_SA(1, 0), a3, voffA);
            PG8_WAIT_V(8); PG8_WAIT_L(0); PG8_BAR; PG8_MMA(1, 0, At, B0); PG8_MMA(1, 1, At, B1); PG8_BAR; PG8_SCHED;
            } else {
            PG8_LDB(B0, 0, 0); PG8_SCHED; PG8_LDA(At, 0, 0); PG8_STAGE(PG8_SA(1, 1), a1 + hstep, voffA);
            PG8_WAIT_L(8); PG8_BAR; PG8_WAIT_L(0); PG8_MMA(0, 0, At, B0); PG8_BAR; PG8_SCHED;
            PG8_LDB(B1, 0, 1); PG8_STAGE(PG8_SB(0, 0), b2, voffB);
            PG8_BAR; PG8_WAIT_L(0); PG8_MMA(0, 1, At, B1); PG8_BAR;
            PG8_LDA(At, 0, 1); PG8_STAGE(PG8_SA(0, 0), a2, voffA);
            PG8_BAR; PG8_WAIT_L(0); PG8_MMA(1, 0, At, B0); PG8_BAR; PG8_SCHED;
            PG8_STAGE(PG8_SB(0, 1), b2 + hstep, voffB);
            PG8_WAIT_V(6); PG8_BAR; PG8_MMA(1, 1, At, B1); PG8_BAR;
            PG8_LDB(B0, 1, 0); PG8_SCHED; PG8_LDA(At, 1, 0); PG8_STAGE(PG8_SA(0, 1), a2 + hstep, voffA);
            PG8_WAIT_L(8); PG8_BAR; PG8_WAIT_L(0); PG8_MMA(0, 0, At, B0); PG8_BAR; PG8_SCHED;
            PG8_LDB(B1, 1, 1); PG8_STAGE(PG8_SB(1, 0), b3, voffB);
            PG8_BAR; PG8_WAIT_L(0); PG8_MMA(0, 1, At, B1); PG8_BAR;
            PG8_LDA(At, 1, 1); PG8_STAGE(PG8_SA(1, 0), a3, voffA);
            PG8_BAR; PG8_WAIT_L(0); PG8_MMA(1, 0, At, B0); PG8_BAR; PG8_SCHED;
            PG8_STAGE(PG8_SB(1, 1), b3 + hstep, voffB);
            PG8_WAIT_V(6); PG8_BAR; PG8_MMA(1, 1, At, B1); PG8_BAR;
            }
        }
        if constexpr (ALIGN_EPI) { if (wr == 0) PG8_BAR; }
        E(acc, cur, wr, wc, fr, fq);
        if (!has_next) break;
#pragma unroll
        for (int a = 0; a < 2; ++a)
#pragma unroll
            for (int b = 0; b < 2; ++b)
#pragma unroll
                for (int m = 0; m < 4; ++m)
#pragma unroll
                    for (int n = 0; n < 2; ++n) acc[a][b][m][n] = (f32x4){0.f, 0.f, 0.f, 0.f};
        cur = nxt; cA = nA; cB = nB; ++ui;
        if constexpr (ALIGN_EPI) { if (wr == 1) PG8_BAR; }
    }
    PG8_WAIT_V(0);
    if constexpr (!ALIGN_EPI) { if (wr == 0) PG8_BAR; }
    PG8_BAR;
#undef PG8_SA
#undef PG8_SB
#undef PG8_STAGE
#undef PG8_LDA
#undef PG8_LDB
#undef PG8_MMA
#undef PG8_WAIT_V
#undef PG8_WAIT_L
#undef PG8_BAR
#undef PG8_SCHED
}
}

namespace at {
constexpr int PITCH = DIN, OPITCH = DM, SLOTB = 8192;
constexpr int L_K = 0, L_V = 2 * SLOTB, L_WS = 4 * SLOTB, L_OST = L_WS + 2048, L_BIAS = L_OST + 8 * 4096, L_END = L_BIAS + 2048;
__device__ __forceinline__ int crow(int r, int hi) { return (r & 3) + 8 * (r >> 2) + 4 * hi; }
__device__ __forceinline__ void glds16(const void* gsrc, unsigned lds_dst) { unsigned keep;
    asm volatile("s_mov_b32 %0, m0\n\ts_mov_b32 m0, %2\n\ts_nop 0\n\tglobal_load_lds_dwordx4 %1, off\n\ts_mov_b32 m0, %0" : "=&s"(keep) : "v"(gsrc), "s"(lds_dst) : "memory"); }
__device__ __forceinline__ unsigned cvtpk_s(float lo, float hi) { typedef __bf16 bf16x2_t __attribute__((ext_vector_type(2))); f32x2 v = {lo, hi}; bf16x2_t b = __builtin_convertvector(v, bf16x2_t); return __builtin_bit_cast(unsigned, b); }
#define AT_WAIT_BAR(N) asm volatile("s_waitcnt vmcnt(" #N ") lgkmcnt(0)\n\ts_barrier" ::: "memory")
#define AT_SBAR() __builtin_amdgcn_sched_barrier(0)

__device__ __forceinline__ void qkt(f32x16& p0, f32x16& p1, const char* Kslot, const bf16x8* qr, int r32, int hi) {
    const char* kb = Kslot + hi * 1024 + r32 * 16;
    const f32x16 z = {};
#pragma unroll
    for (int d0 = 0; d0 < 4; ++d0) {
        const bf16x8 b0 = *reinterpret_cast<const bf16x8*>(kb + d0 * 2048);
        const bf16x8 b1 = *reinterpret_cast<const bf16x8*>(kb + d0 * 2048 + 512);
        if (d0 == 0) { p0 = __builtin_amdgcn_mfma_f32_32x32x16_bf16(b0, qr[0], z, 0, 0, 0); p1 = __builtin_amdgcn_mfma_f32_32x32x16_bf16(b1, qr[0], z, 0, 0, 0); }
        else { p0 = __builtin_amdgcn_mfma_f32_32x32x16_bf16(b0, qr[d0], p0, 0, 0, 0); p1 = __builtin_amdgcn_mfma_f32_32x32x16_bf16(b1, qr[d0], p1, 0, 0, 0); } }
}
__device__ __forceinline__ float rowmax(const f32x16& p0, const f32x16& p1) {
    float a = fmaxf(p0[0], p1[0]);
#pragma unroll
    for (int r = 1; r < 16; ++r) a = fmaxf(a, fmaxf(p0[r], p1[r]));
    return fmaxf(a, __shfl_xor(a, 32));
}
__device__ __forceinline__ void pv(f32x16* o, int vb, bf16x8 pa0, bf16x8 pa1, bf16x8 pa2, bf16x8 pa3) {
#pragma unroll
    for (int d0 = 0; d0 < 2; ++d0) { s16x4 lo[4], hi[4];
#pragma unroll
        for (int ks = 0; ks < 4; ++ks) {
            asm volatile("ds_read_b64_tr_b16 %0,%1 offset:%c2" : "=&v"(lo[ks]) : "v"(vb), "i"(d0 * 4096 + ks * 1024) : "memory");
            asm volatile("ds_read_b64_tr_b16 %0,%1 offset:%c2" : "=&v"(hi[ks]) : "v"(vb), "i"(d0 * 4096 + ks * 1024 + 512) : "memory"); }
        asm volatile("s_waitcnt lgkmcnt(0)" ::: "memory"); AT_SBAR();
#define AT_PK(k) (bf16x8){lo[k][0], lo[k][1], lo[k][2], lo[k][3], hi[k][0], hi[k][1], hi[k][2], hi[k][3]}
        o[d0] = __builtin_amdgcn_mfma_f32_32x32x16_bf16(pa0, AT_PK(0), o[d0], 0, 0, 0);
        o[d0] = __builtin_amdgcn_mfma_f32_32x32x16_bf16(pa1, AT_PK(1), o[d0], 0, 0, 0);
        o[d0] = __builtin_amdgcn_mfma_f32_32x32x16_bf16(pa2, AT_PK(2), o[d0], 0, 0, 0);
        o[d0] = __builtin_amdgcn_mfma_f32_32x32x16_bf16(pa3, AT_PK(3), o[d0], 0, 0, 0);
#undef AT_PK
    }
}
__device__ __forceinline__ void store_tile(const f32x16* o, const float* rli, bf16_t* stg, bf16_t* Ow, int pitch, float* ss, int lane, int r32, int hi) {
#pragma unroll
    for (int r = 0; r < 16; ++r) { const int orow = crow(r, hi);
#pragma unroll
        for (int d0 = 0; d0 < 2; ++d0) stg[orow * 64 + d0 * 32 + r32] = (bf16_t)(cvtpk_s(o[d0][r] * rli[r], 0.f) & 0xffffu); }
    asm volatile("s_waitcnt lgkmcnt(0)" ::: "memory");
#pragma unroll
    for (int i = 0; i < 4; ++i) { const int row = i * 8 + (lane >> 3), ch = lane & 7; const u32x4 v = *(const u32x4*)(stg + row * 64 + ch * 8);
        { const bf16_t* gp_ = Ow + (long)row * pitch + ch * 8; asm volatile("global_store_dwordx4 %0, %1, off sc0 sc1\n\ts_nop 1" :: "v"(gp_), "v"(v) : "memory"); }
        float s = 0.f;
#pragma unroll
        for (int j = 0; j < 4; ++j) { const float a = __uint_as_float(v[j] << 16), b = __uint_as_float(v[j] & 0xffff0000u); s += a * a + b * b; }
        s += __shfl_xor(s, 1); s += __shfl_xor(s, 2); s += __shfl_xor(s, 4);
        if (ch == 0) atomicAdd(ss + (long)row * 4, s); }
    asm volatile("s_waitcnt lgkmcnt(0)" ::: "memory");
}

struct Job { const bf16_t* Q; const bf16_t* Kc; const bf16_t* Vc; const bf16_t* Kl; const bf16_t* Vl; bf16_t* O; float* ss; int nctx, lt0, nlt, r0; };
template <int MODE> __device__ __forceinline__ void unit(const Job& J, char* shm) {
    const int tid = opaque_tid(), lane = tid & 63, r32 = lane & 31, hi = lane >> 5; const int wid = __builtin_amdgcn_readfirstlane(tid >> 6);
    const unsigned lds0 = (unsigned)(uintptr_t)shm;
    float* wsf = (float*)(shm + L_WS) + wid * 64;
    const long koff = (long)lane * PITCH + wid * 8;
    const long voff = (long)(16 * (wid & 3) + (lane >> 2)) * PITCH + (wid >> 2) * 32 + (lane & 3) * 8;
    const unsigned kdst = lds0 + L_K + wid * 1024, vdst = lds0 + L_V + wid * 1024;
    const int nt = J.nctx + J.nlt;
#define AT_DMA(t, slot) do { const int t_ = (t); const bf16_t* kp_ = (t_ < J.nctx) ? J.Kc + (long)t_ * 64 * PITCH : J.Kl + (long)(J.lt0 + t_ - J.nctx) * 64 * PITCH; \
        const bf16_t* vp_ = (t_ < J.nctx) ? J.Vc + (long)t_ * 64 * PITCH : J.Vl + (long)(J.lt0 + t_ - J.nctx) * 64 * PITCH; \
        glds16(kp_ + koff, (unsigned)__builtin_amdgcn_readfirstlane(kdst + (slot))); glds16(vp_ + voff, (unsigned)__builtin_amdgcn_readfirstlane(vdst + (slot))); } while (0)
    AT_DMA(0, 0);
    bf16x8 qr[4];
    const bf16_t* Qw = J.Q + (long)(wid * 32 + r32) * PITCH;
#pragma unroll
    for (int d0 = 0; d0 < 4; ++d0) qr[d0] = *reinterpret_cast<const bf16x8*>(Qw + d0 * 16 + hi * 8);
    float m_run = -INFINITY, l_reg = 0.f; f32x16 o[2]; o[0] = f32x16{}; o[1] = f32x16{};
    int gr = 0, rs = 0, qc = 0, cs = 0;
    if (MODE == 1) { gr = J.r0 + (wid >> 1); rs = min(max(gr - 4, 0), 120); qc = 32 * (wid & 1) + r32; cs = min(max(qc - 8, 0), 48); }
    const int vb0 = (int)(lds0 + L_V) + ((lane >> 4) & 1) * 32 + (lane & 3) * 8 + (4 * hi + ((lane & 15) >> 2)) * 64;
    for (int t = 0; t < nt; ++t) {
        const int sl = (t & 1) * SLOTB;
        if (t + 1 < nt) { AT_DMA(t + 1, ((t + 1) & 1) * SLOTB); AT_WAIT_BAR(2); } else { AT_WAIT_BAR(0); }
        bool active = true; int dr = 0;
        if (MODE == 1 && t >= J.nctx) { const int kr = J.lt0 + t - J.nctx; active = (unsigned)(kr - rs) < 8u; dr = kr - gr + 7; }
        if (active) {
            f32x16 p0, p1; qkt(p0, p1, shm + L_K + sl, qr, r32, hi);
            if (MODE == 1 && t >= J.nctx) {
                const float* bl = (const float*)(shm + L_BIAS) + dr * 31 + 15 - qc;
#pragma unroll
                for (int r = 0; r < 16; ++r) { const int kc = crow(r, hi);
                    const bool v0 = (unsigned)(kc - cs) < 16u, v1 = (unsigned)(kc + 32 - cs) < 16u;
                    const float b0 = bl[v0 ? kc : qc], b1 = bl[v1 ? kc + 32 : qc];
                    p0[r] = v0 ? p0[r] + b0 : -INFINITY; p1[r] = v1 ? p1[r] + b1 : -INFINITY; }
            }
            const float rm = rowmax(p0, p1);
            const float mnew = fmaxf(m_run, rm);
            if (__any(mnew > m_run)) {
                const float f = __builtin_amdgcn_exp2f(m_run - mnew); l_reg *= f; m_run = mnew;
                if (hi == 0) wsf[r32] = f;
                asm volatile("s_waitcnt lgkmcnt(0)" ::: "memory");
#pragma unroll
                for (int r = 0; r < 16; ++r) { const float fr_ = wsf[crow(r, hi)]; o[0][r] *= fr_; o[1][r] *= fr_; }
            }
            float sacc = 0.f;
#pragma unroll
            for (int r = 0; r < 16; ++r) { p0[r] = __builtin_amdgcn_exp2f(p0[r] - m_run); p1[r] = __builtin_amdgcn_exp2f(p1[r] - m_run); sacc += p0[r] + p1[r]; }
            l_reg += sacc;
            u32x4 pw0, pw1, pw2, pw3;
            pw0 = (u32x4){cvtpk_s(p0[0], p0[1]), cvtpk_s(p0[2], p0[3]), cvtpk_s(p0[4], p0[5]), cvtpk_s(p0[6], p0[7])};
            pw1 = (u32x4){cvtpk_s(p0[8], p0[9]), cvtpk_s(p0[10], p0[11]), cvtpk_s(p0[12], p0[13]), cvtpk_s(p0[14], p0[15])};
            pw2 = (u32x4){cvtpk_s(p1[0], p1[1]), cvtpk_s(p1[2], p1[3]), cvtpk_s(p1[4], p1[5]), cvtpk_s(p1[6], p1[7])};
            pw3 = (u32x4){cvtpk_s(p1[8], p1[9]), cvtpk_s(p1[10], p1[11]), cvtpk_s(p1[12], p1[13]), cvtpk_s(p1[14], p1[15])};
            AT_SBAR();
            pv(o, vb0 + sl, __builtin_bit_cast(bf16x8, pw0), __builtin_bit_cast(bf16x8, pw1), __builtin_bit_cast(bf16x8, pw2), __builtin_bit_cast(bf16x8, pw3));
        }
        asm volatile("s_waitcnt lgkmcnt(0)\n\ts_barrier" ::: "memory");
    }
#undef AT_DMA
    l_reg += __shfl_xor(l_reg, 32);
    if (hi == 0) wsf[32 + r32] = l_reg;
    asm volatile("s_waitcnt lgkmcnt(0)" ::: "memory");
    float rli[16];
#pragma unroll
    for (int r = 0; r < 16; ++r) rli[r] = __builtin_amdgcn_rcpf(wsf[32 + crow(r, hi)]);
    store_tile(o, rli, (bf16_t*)(shm + L_OST) + wid * 2048, J.O + (long)(wid * 32) * OPITCH, OPITCH, J.ss + (long)(wid * 32) * 4, lane, r32, hi);
    asm volatile("s_waitcnt vmcnt(0) lgkmcnt(0)\n\ts_barrier" ::: "memory");
}
}


namespace ap {
using at::crow; using at::glds16; using at::cvtpk_s;
constexpr int PITCH = DIN, OPITCH = DM, KVBLK = 64, QBLK = 32, NW = 8;
#define SBAR() __builtin_amdgcn_sched_barrier(0)
constexpr int NSLOT = 3, SLOTB = 8192;
constexpr int LDS_K = 0, LDS_V = NSLOT * SLOTB, LDS_WS = 2 * NSLOT * SLOTB, LDS_OST = LDS_WS + NW * 64 * 4, LDS_BYTES_ = LDS_OST + NW * 4096;
__device__ __forceinline__ float max3f(float a, float b, float c) { float r; asm("v_max3_f32 %0, %1, %2, %3" : "=v"(r) : "v"(a), "v"(b), "v"(c)); return r; }
__device__ __forceinline__ float max2f(float a, float b) { float r; asm("v_max_f32_e32 %0, %1, %2" : "=v"(r) : "v"(a), "v"(b)); return r; }
__device__ __forceinline__ float fadd_s(float a, float b) { float r; asm("v_add_f32_e32 %0, %1, %2" : "=v"(r) : "v"(a), "v"(b)); return r; }
__device__ __forceinline__ float fsub_s(float a, float b) { float r; asm("v_sub_f32_e32 %0, %1, %2" : "=v"(r) : "v"(a), "v"(b)); return r; }
#define WAIT_BAR(N) asm volatile("s_waitcnt vmcnt(" #N ") lgkmcnt(0)\n\ts_barrier" ::: "memory")
__device__ __forceinline__ void qkt(f32x16& p0, f32x16& p1, const char* Kslot, const bf16x8* qr, const f32x16& negm, int r32, int hi) {
    const char* kb = Kslot + hi * 1024 + r32 * 16;
#pragma unroll
    for (int d0 = 0; d0 < 4; ++d0) {
        const bf16x8 b0 = *reinterpret_cast<const bf16x8*>(kb + d0 * 2048);
        const bf16x8 b1 = *reinterpret_cast<const bf16x8*>(kb + d0 * 2048 + 512);
        if (d0 == 0) { p0 = __builtin_amdgcn_mfma_f32_32x32x16_bf16(b0, qr[0], negm, 0, 0, 0); p1 = __builtin_amdgcn_mfma_f32_32x32x16_bf16(b1, qr[0], negm, 0, 0, 0); }
        else { p0 = __builtin_amdgcn_mfma_f32_32x32x16_bf16(b0, qr[d0], p0, 0, 0, 0); p1 = __builtin_amdgcn_mfma_f32_32x32x16_bf16(b1, qr[d0], p1, 0, 0, 0); } }
}
typedef __attribute__((address_space(3))) const char* lds_cptr;
typedef short v4i16_t __attribute__((ext_vector_type(4)));
__device__ __forceinline__ void kload8(bf16x8* kf, lds_cptr kp) {
    kf[0] = *(const LAS bf16x8*)(kp);        kf[1] = *(const LAS bf16x8*)(kp + 512);
    kf[2] = *(const LAS bf16x8*)(kp + 2048); kf[3] = *(const LAS bf16x8*)(kp + 2560);
    kf[4] = *(const LAS bf16x8*)(kp + 4096); kf[5] = *(const LAS bf16x8*)(kp + 4608);
    kf[6] = *(const LAS bf16x8*)(kp + 6144); kf[7] = *(const LAS bf16x8*)(kp + 6656);
}
__device__ __forceinline__ void kload2(bf16x8* kf, lds_cptr kp, int j) { kf[2 * j] = *(const LAS bf16x8*)(kp + j * 2048); kf[2 * j + 1] = *(const LAS bf16x8*)(kp + j * 2048 + 512); }
__device__ __forceinline__ s16x4 vtr(lds_cptr p) { return __builtin_bit_cast(s16x4, __builtin_amdgcn_ds_read_tr16_b64_v4i16((LAS v4i16_t*)p)); }
__device__ __forceinline__ float rowmax(const f32x16& p0, const f32x16& p1) {
    float a = max3f(p0[0], p0[1], p1[0]), b = max3f(p0[2], p0[3], p1[1]); a = max3f(a, p1[2], p1[3]);
#pragma unroll
    for (int r = 4; r < 16; r += 4) { a = max3f(a, p0[r], p0[r + 1]); b = max3f(b, p0[r + 2], p0[r + 3]); a = max3f(a, p1[r], p1[r + 1]); b = max3f(b, p1[r + 2], p1[r + 3]); }
    const float m = max2f(a, b);
    auto rr = __builtin_amdgcn_permlane32_swap(__float_as_uint(m), __float_as_uint(m), false, false);
    return max2f(__uint_as_float(rr[0]), __uint_as_float(rr[1]));
}
__device__ __forceinline__ void glds16s(unsigned voff, const void* sbase, unsigned lds_dst) { unsigned keep;
    asm volatile("s_mov_b32 %0, m0\n\ts_mov_b32 m0, %3\n\ts_nop 0\n\tglobal_load_lds_dwordx4 %1, %2\n\ts_mov_b32 m0, %0" : "=&s"(keep) : "v"(voff), "s"(sbase), "s"(lds_dst) : "memory"); }
constexpr int LDS_NABIAS = 86016;
template <int THRL, int MODE> __device__ __forceinline__ void unit(const bf16_t* Q, const bf16_t* __restrict__ Kh, const bf16_t* __restrict__ Vh, bf16_t* O, float* ss, const int NT, char* shm, const int lt0, const int r0, const float bref = 0.f) {
    const int tid = opaque_tid(), lane = tid & 63, r32 = lane & 31, hi = lane >> 5; const int wid = __builtin_amdgcn_readfirstlane(tid >> 6);
    const bf16_t* Qw = Q + (long)(wid * QBLK) * PITCH;
    const unsigned lds0 = (unsigned)(uintptr_t)shm;
    float* wsf = (float*)(shm + LDS_WS) + wid * 64;
    const unsigned kvo = (unsigned)((lane * PITCH + wid * 8) * 2);
    const unsigned vvo = (unsigned)(((16 * (wid & 3) + (lane >> 2)) * PITCH + (wid >> 2) * 32 + (lane & 3) * 8) * 2);
    const unsigned kdst = lds0 + LDS_K + wid * 1024, vdst = lds0 + LDS_V + wid * 1024;
#define TROW(t) (MODE == 1 ? ((t) < 4 ? SEQ + 64 * (t) : 64 * (lt0 + (t) - 4)) : 64 * (t))
#define DMA_K(t, slot) glds16s(kvo, Kh + (long)TROW(t) * PITCH, (unsigned)__builtin_amdgcn_readfirstlane(kdst + (slot)))
#define DMA_V(t, slot) glds16s(vvo, Vh + (long)TROW(t) * PITCH, (unsigned)__builtin_amdgcn_readfirstlane(vdst + (slot)))
    const char* Kbase = shm + LDS_K; bf16x8 kf[8];
    const lds_cptr shm3 = (lds_cptr)shm; const lds_cptr kp0 = shm3 + LDS_K + hi * 1024 + r32 * 16; const lds_cptr vp0 = shm3 + LDS_V + ((lane >> 4) & 1) * 32 + (lane & 3) * 8 + (4 * hi + ((lane & 15) >> 2)) * 64;
    DMA_K(0, 0); DMA_V(0, 0); DMA_K(1, SLOTB);
    bf16x8 qr[4];
#pragma unroll
    for (int d0 = 0; d0 < 4; ++d0) qr[d0] = *reinterpret_cast<const bf16x8*>(&Qw[(long)r32 * PITCH + d0 * 16 + hi * 8]);
    float mhat = (MODE == 0) ? bref : 0.f, l_reg = 0.f; f32x16 o[2]; o[0] = f32x16{}; o[1] = f32x16{}; f32x16 negm = f32x16{};
    if (MODE == 0) { _Pragma("unroll") for (int r = 0; r < 16; ++r) negm[r] = -bref; }
    if (MODE != 1) asm volatile("" : "+v"(negm));
    int na_gr = 0, na_rs = 0, na_qc = 0, na_cs = 0;
    if (MODE == 1) { na_gr = r0 + (wid >> 1); na_rs = min(max(na_gr - 4, 0), 120); na_qc = 32 * (wid & 1) + r32; na_cs = min(max(na_qc - 8, 0), 48); }
#define CMASK(P0, P1, t) do { if (MODE == 1) { if ((t) >= 4) { const int kr_ = lt0 + (t) - 4; \
        if ((unsigned)(kr_ - na_rs) < 8u) { const float* bl_ = (const float*)(shm + LDS_NABIAS) + (kr_ - na_gr + 7) * 31 + 15 - na_qc; \
            _Pragma("unroll") for (int r4 = 0; r4 < 16; r4 += 4) { \
                _Pragma("unroll") for (int r = r4; r < r4 + 4; ++r) { const int kc_ = crow(r, hi); const bool v0_ = (unsigned)(kc_ - na_cs) < 16u, v1_ = (unsigned)(kc_ + 32 - na_cs) < 16u; \
                    const float b0_ = bl_[kc_], b1_ = bl_[kc_ + 32];        P0[r] = v0_ ? P0[r] + (b0_ - mhat) : -INFINITY; P1[r] = v1_ ? P1[r] + (b1_ - mhat) : -INFINITY; } \
                SBAR(); } } \
        else { _Pragma("unroll") for (int r = 0; r < 16; ++r) { P0[r] = -INFINITY; P1[r] = -INFINITY; } } } \
      else { _Pragma("unroll") for (int r = 0; r < 16; ++r) { P0[r] -= mhat; P1[r] -= mhat; } } } } while (0)
#define NEGMC (MODE == 1 ? (f32x16){0.f, 0.f, 0.f, 0.f, 0.f, 0.f, 0.f, 0.f, 0.f, 0.f, 0.f, 0.f, 0.f, 0.f, 0.f, 0.f} : negm)
    bool resc = false;
#define START(P0, P1) do { resc = false; \
    if (MODE == 1) { const float rm = rowmax(P0, P1); const float dl = rm; mhat = fadd_s(mhat, dl); \
      _Pragma("unroll") for (int r = 0; r < 16; ++r) { P0[r] = fsub_s(P0[r], dl); P1[r] = fsub_s(P1[r], dl); } \
      if (MODE != 1) { _Pragma("unroll") for (int r = 0; r < 16; ++r) negm[r] = -mhat; asm volatile("" : "+v"(negm)); } } \
    _Pragma("unroll") for (int r = 0; r < 16; ++r) P0[r] = __builtin_amdgcn_exp2f(P0[r]); } while (0)
#define RESC() do { if (resc) { asm volatile("s_waitcnt lgkmcnt(0)" ::: "memory"); \
      _Pragma("unroll") for (int d_ = 0; d_ < 2; ++d_) _Pragma("unroll") for (int r = 0; r < 16; ++r) o[d_][r] *= wsf[crow(r, hi)]; } } while (0)
    f32x16 pA0, pA1, pB0, pB1;
    int sl_prev = 0, sl_cur = 0, sl_next = SLOTB;
#define ROT() do { sl_prev = sl_cur; sl_cur = sl_next; sl_next = (sl_next == (NSLOT - 1) * SLOTB) ? 0 : sl_next + SLOTB; } while (0)
    DMA_K(2, 2 * SLOTB);
    WAIT_BAR(3);
    qkt(pA0, pA1, Kbase, qr, negm, r32, hi); asm volatile("s_nop 15\n\ts_nop 7" : "+v"(pA0), "+v"(pA1));
    START(pA0, pA1);
    _Pragma("unroll") for (int r = 0; r < 16; ++r) pA1[r] = __builtin_amdgcn_exp2f(pA1[r]);
    WAIT_BAR(0);
    DMA_K(3, 0); DMA_V(1, SLOTB);
    ROT();
    kload8(kf, kp0 + sl_cur);
    WAIT_BAR(2);
    s16x4 vlo[8], vhi[8]; u32x4 pw0, pw1, pw2, pw3;
#define PKW(P, B) cvtpk_s(P[B], P[B + 1])
#define PAF(k) __builtin_bit_cast(bf16x8, pw##k)
#define VFR(i) (bf16x8){vlo[i][0], vlo[i][1], vlo[i][2], vlo[i][3], vhi[i][0], vhi[i][1], vhi[i][2], vhi[i][3]}
#define PIN(x) asm volatile("" : "+v"(x))
#define MX3(a, b, c) __builtin_fmaxf(__builtin_fmaxf((a), (b)), (c))
#define GAPA(MF, A0, A1, A2, A3, W0, W1, PW) do { MF; sacc += A0; sacc += A1; sacc += A2; sacc += A3; PIN(sacc); W0; W1; PIN(PW); SBAR(); } while (0)
#define EX(v) __builtin_amdgcn_exp2f(v)
#define GAPB(MF, X, B) do { MF; X[B] = EX(X[B]); X[B + 1] = EX(X[B + 1]); X[B + 2] = EX(X[B + 2]); X[B + 3] = EX(X[B + 3]); PIN(X); SBAR(); } while (0)
#define VRD(i) do { vlo[i] = vtr(vp_ + (((i) >> 2) * 4096 + ((i) & 3) * 1024)); vhi[i] = vtr(vp_ + (((i) >> 2) * 4096 + ((i) & 3) * 1024 + 512)); } while (0)
#define KRD(G, j) do { if (G) { kload2(kf, kp0 + sl_next, j); SBAR(); } } while (0)
#define STEP(C0, C1, P0, P1, t, GK, GV, GL) do { SBAR(); \
    const lds_cptr vp_ = vp0 + sl_prev; \
    VRD(0); SBAR(); float sacc = (P0[0] + P0[1]); \
    GAPA(C0 = __builtin_amdgcn_mfma_f32_32x32x16_bf16(kf[0], qr[0], NEGMC, 0, 0, 0), P0[2], P0[3], P0[4], P0[5],     pw0[0] = PKW(P0, 0), pw0[1] = PKW(P0, 2), pw0); \
    VRD(4); SBAR(); GAPA(C1 = __builtin_amdgcn_mfma_f32_32x32x16_bf16(kf[1], qr[0], NEGMC, 0, 0, 0), P0[6], P0[7], P0[8], P0[9],     pw0[2] = PKW(P0, 4), pw0[3] = PKW(P0, 6), pw0); \
    VRD(1); SBAR(); GAPA(C0 = __builtin_amdgcn_mfma_f32_32x32x16_bf16(kf[2], qr[1], C0, 0, 0, 0),   P0[10], P0[11], P0[12], P0[13], pw1[0] = PKW(P0, 8), pw1[1] = PKW(P0, 10), pw1); \
    VRD(5); SBAR(); GAPA(C1 = __builtin_amdgcn_mfma_f32_32x32x16_bf16(kf[3], qr[1], C1, 0, 0, 0),   P0[14], P0[15], P1[0], P1[1],   pw1[2] = PKW(P0, 12), pw1[3] = PKW(P0, 14), pw1); \
    VRD(2); SBAR(); GAPA(C0 = __builtin_amdgcn_mfma_f32_32x32x16_bf16(kf[4], qr[2], C0, 0, 0, 0),   P1[2], P1[3], P1[4], P1[5],     pw2[0] = PKW(P1, 0), pw2[1] = PKW(P1, 2), pw2); \
    VRD(6); SBAR(); GAPA(C1 = __builtin_amdgcn_mfma_f32_32x32x16_bf16(kf[5], qr[2], C1, 0, 0, 0),   P1[6], P1[7], P1[8], P1[9],     pw2[2] = PKW(P1, 4), pw2[3] = PKW(P1, 6), pw2); \
    VRD(3); SBAR(); GAPA(C0 = __builtin_amdgcn_mfma_f32_32x32x16_bf16(kf[6], qr[3], C0, 0, 0, 0),   P1[10], P1[11], P1[12], P1[13], pw3[0] = PKW(P1, 8), pw3[1] = PKW(P1, 10), pw3); \
    VRD(7); SBAR(); GAPA(C1 = __builtin_amdgcn_mfma_f32_32x32x16_bf16(kf[7], qr[3], C1, 0, 0, 0),   P1[14], P1[15], 0.f, 0.f,       pw3[2] = PKW(P1, 12), pw3[3] = PKW(P1, 14), pw3); \
    l_reg += sacc; \
    if (GK) { DMA_K((t) + 3, sl_cur); } if (GV) { DMA_V((t) + 1, sl_next); } \
    CMASK(C0, C1, t); \
    if (MODE == 1) { float a = MX3(C0[0], C0[1], C1[0]), b = MX3(C0[2], C0[3], C1[1]); a = MX3(a, C1[2], C1[3]); \
      _Pragma("unroll") for (int r = 4; r < 16; r += 4) { a = MX3(a, C0[r], C0[r + 1]); b = MX3(b, C0[r + 2], C0[r + 3]); a = MX3(a, C1[r], C1[r + 1]); b = MX3(b, C1[r + 2], C1[r + 3]); } \
      float rm = __builtin_fmaxf(a, b); { auto rr = __builtin_amdgcn_permlane32_swap(__float_as_uint(rm), __float_as_uint(rm), false, false); rm = __builtin_fmaxf(__uint_as_float(rr[0]), __uint_as_float(rr[1])); } \
      resc = false; \
      if (__builtin_expect(__any(rm > (float)THRL), 0)) { const float dl = __builtin_fmaxf(rm, 0.f); mhat += dl; \
        _Pragma("unroll") for (int r = 0; r < 16; ++r) { C0[r] -= dl; C1[r] -= dl; } \
        if (MODE != 1) { _Pragma("unroll") for (int r = 0; r < 16; ++r) negm[r] = -mhat; asm volatile("" : "+v"(negm)); } \
        const float f = __builtin_amdgcn_exp2f(-dl); l_reg *= f; if (hi == 0) wsf[r32] = f; resc = true; } } \
    SBAR(); \
    GAPB(o[0] = __builtin_amdgcn_mfma_f32_32x32x16_bf16(PAF(0), VFR(0), o[0], 0, 0, 0), C0, 0); \
    GAPB(o[1] = __builtin_amdgcn_mfma_f32_32x32x16_bf16(PAF(0), VFR(4), o[1], 0, 0, 0), C0, 4); \
    KRD(GL, 0); GAPB(o[0] = __builtin_amdgcn_mfma_f32_32x32x16_bf16(PAF(1), VFR(1), o[0], 0, 0, 0), C0, 8); \
    KRD(GL, 1); GAPB(o[1] = __builtin_amdgcn_mfma_f32_32x32x16_bf16(PAF(1), VFR(5), o[1], 0, 0, 0), C0, 12); \
    KRD(GL, 2); GAPB(o[0] = __builtin_amdgcn_mfma_f32_32x32x16_bf16(PAF(2), VFR(2), o[0], 0, 0, 0), C1, 0); \
    KRD(GL, 3); GAPB(o[1] = __builtin_amdgcn_mfma_f32_32x32x16_bf16(PAF(2), VFR(6), o[1], 0, 0, 0), C1, 4); \
    GAPB(o[0] = __builtin_amdgcn_mfma_f32_32x32x16_bf16(PAF(3), VFR(3), o[0], 0, 0, 0), C1, 8); \
    GAPB(o[1] = __builtin_amdgcn_mfma_f32_32x32x16_bf16(PAF(3), VFR(7), o[1], 0, 0, 0), C1, 12); \
    } while (0)
    int t = 1;
    for (; t + 5 < NT; t += 2) {
        STEP(pB0, pB1, pA0, pA1, t, true, true, true);     WAIT_BAR(2); RESC(); ROT();
        STEP(pA0, pA1, pB0, pB1, t + 1, true, true, true); WAIT_BAR(2); RESC(); ROT();
    }
#define ENDW(tt) do { if ((tt) + 3 < NT) { WAIT_BAR(2); } else if ((tt) + 2 < NT) { WAIT_BAR(1); } else { WAIT_BAR(0); } } while (0)
    for (; t + 1 < NT; t += 2) {
        STEP(pB0, pB1, pA0, pA1, t, (t + 3 < NT), (t + 1 < NT), (t + 1 < NT));         ENDW(t);     RESC(); ROT();
        STEP(pA0, pA1, pB0, pB1, t + 1, (t + 4 < NT), (t + 2 < NT), (t + 2 < NT));     ENDW(t + 1); RESC(); ROT();
    }
    STEP(pB0, pB1, pA0, pA1, NT - 1, false, false, false); RESC();
    { float sacc = pB0[0] + pB0[1]; _Pragma("unroll") for (int r = 2; r < 16; ++r) sacc += pB0[r]; _Pragma("unroll") for (int r = 0; r < 16; ++r) sacc += pB1[r]; l_reg += sacc;
      pw0 = (u32x4){PKW(pB0, 0), PKW(pB0, 2), PKW(pB0, 4), PKW(pB0, 6)}; pw1 = (u32x4){PKW(pB0, 8), PKW(pB0, 10), PKW(pB0, 12), PKW(pB0, 14)}; pw2 = (u32x4){PKW(pB1, 0), PKW(pB1, 2), PKW(pB1, 4), PKW(pB1, 6)}; pw3 = (u32x4){PKW(pB1, 8), PKW(pB1, 10), PKW(pB1, 12), PKW(pB1, 14)};
      SBAR(); const int vb0 = (int)(lds0 + LDS_V) + ((lane >> 4) & 1) * 32 + (lane & 3) * 8 + (4 * hi + ((lane & 15) >> 2)) * 64;
      at::pv(o, vb0 + sl_cur, PAF(0), PAF(1), PAF(2), PAF(3)); }
#undef PKW
#undef PAF
#undef VFR
#undef PIN
#undef MX3
#undef GAPA
#undef GAPB
#undef EX
#undef VRD
#undef KRD
#undef STEP
#undef ENDW
    { auto rr = __builtin_amdgcn_permlane32_swap(__float_as_uint(l_reg), __float_as_uint(l_reg), false, false); l_reg = __uint_as_float(rr[0]) + __uint_as_float(rr[1]); }
    if (hi == 0) wsf[32 + r32] = l_reg; asm volatile("s_waitcnt lgkmcnt(0)" ::: "memory");
    float rli[16];
#pragma unroll
    for (int r = 0; r < 16; ++r) rli[r] = __builtin_amdgcn_rcpf(wsf[32 + crow(r, hi)]);
    at::store_tile(o, rli, (bf16_t*)(shm + LDS_OST) + wid * 2048, O + (long)(wid * QBLK) * OPITCH, OPITCH, ss + (long)(wid * QBLK) * 4, lane, r32, hi);
    asm volatile("s_waitcnt vmcnt(0) lgkmcnt(0)\n\ts_barrier" ::: "memory");
#undef DMA_K
#undef DMA_V
#undef TROW
#undef CMASK
#undef NEGMC
#undef START
#undef RESC
#undef ROT
}
#undef SBAR
#undef WAIT_BAR
}

constexpr size_t MiB = 1u << 20;
constexpr size_t WS_CTL = 0;
constexpr size_t CTL_BYTES = 131072;
constexpr size_t WS_MOD = 1 * MiB;
constexpr size_t WS_ROPE = WS_MOD + 512 * 1024;
constexpr size_t WS_SS = 2 * MiB;
constexpr size_t WS_WS = 3 * MiB;
constexpr size_t WS_WIN = 4 * MiB;
constexpr size_t WS_WO = WS_WIN + 4 * (size_t)DIN * DM * 2;
constexpr size_t WS_WF1 = WS_WO + 4 * (size_t)DM * DM * 2;
constexpr size_t WS_WF2 = WS_WF1 + 4 * (size_t)2 * DFF * DM * 2;
constexpr size_t WS_XRES = WS_WF2 + 4 * (size_t)DM * DFF * 2;
constexpr size_t WS_H = WS_XRES + (size_t)MROWS * DM * 4;
constexpr size_t WS_Y = WS_H + (size_t)MROWS * DM * 2;
constexpr size_t WS_QKV = WS_Y + (size_t)MROWS * DM * 2;
constexpr size_t WS_OMIX = WS_QKV + (size_t)MROWS * DIN * 2;
constexpr size_t WS_HID = WS_QKV;
constexpr size_t WS_END = WS_OMIX + (size_t)MROWS * DM * 2;
static_assert((size_t)MROWS * DFF * 2 <= (size_t)MROWS * (DIN + DM) * 2, "hid overlay");
constexpr size_t WS_Y32 = WS_END + MiB;
constexpr size_t WS_TOTAL = WS_Y32 + 11 * 2 * MiB;

constexpr int NWAVES = 8, NTHREADS = 512;
constexpr int RING_BYTES = 131072, LDS_BYTES = 147456;

struct Params {
    const float *x, *c, *ctx, *c_ctx, *w_mod, *b_mod, *w_in, *rpb, *w_s, *b_s, *g_sgu, *g_q, *g_k, *g_out, *w_o, *ln1_g, *ln1_b, *w_ffn_in, *w_ffn_out, *ln2_g, *ln2_b;
    float* out; unsigned char* ws;
};


#define XB_TMO      128
#define XB_XCNT(j)  (256  + 64 * (j))
#define XB_XSUB(j)  (1280 + 64 * (j))
#define XB_XGEN(j)  (2304 + 64 * (j))
#define XB_TOP      3328
#define XB_TOPGEN   3392
#define XCD_BAR_WORDS 3456
#define XB_SPIN_CAP (1u << 22)
__device__ __forceinline__ unsigned xb_ld(unsigned* p)              { return __hip_atomic_load(p, __ATOMIC_RELAXED, __HIP_MEMORY_SCOPE_AGENT); }
__device__ __forceinline__ unsigned xb_add(unsigned* p, unsigned v) { return __hip_atomic_fetch_add(p, v, __ATOMIC_RELAXED, __HIP_MEMORY_SCOPE_AGENT); }
__device__ __forceinline__ unsigned xb_xcc_id() { return (unsigned)__builtin_amdgcn_s_getreg((3 << 11) | 20) & 0xFu; }
#define XB_SPIN(cond, bar) do { unsigned _sp = 0; while (cond) { __builtin_amdgcn_s_sleep(1); \
    if ((++_sp & 255u) == 0u) { if (xb_ld(&(bar)[XB_TMO])) break; if (_sp > XB_SPIN_CAP) { atomicAdd(&(bar)[XB_TMO], 1u); break; } } } } while (0)
struct XcdBarrier { unsigned* bar; unsigned x; volatile LAS unsigned* st; };
__device__ __forceinline__ XcdBarrier xcd_barrier_post(unsigned* bar, volatile LAS unsigned* st) {
    XcdBarrier b; b.bar = bar; b.x = xb_xcc_id(); b.st = st;
    if (threadIdx.x == 0) (void)xb_add(&bar[XB_XCNT(b.x)], 1u);
    return b;
}
__device__ __forceinline__ void xcd_barrier_complete(unsigned* bar, unsigned x, unsigned& nloc, unsigned& nx) {
    const unsigned G = gridDim.x * gridDim.y * gridDim.z;
    unsigned sum, cnt, mine, sp = 0u;
    for (;;) {
        sum = 0u; cnt = 0u; mine = 0u;
#pragma unroll
        for (unsigned j = 0; j < 16; ++j) { const unsigned c = xb_ld(&bar[XB_XCNT(j)]); sum += c; cnt += (c > 0u) ? 1u : 0u; mine = (j == x) ? c : mine; }
        if (sum == G) break;
        __builtin_amdgcn_s_sleep(1);
        if ((++sp & 255u) == 0u) { if (xb_ld(&bar[XB_TMO])) break; if (sp > XB_SPIN_CAP) { atomicAdd(&bar[XB_TMO], 1u); break; } }
    }
    nloc = mine > 0u ? mine : 1u; nx = cnt > 0u ? cnt : 1u;
}
__device__ __forceinline__ void xcd_barrier(const XcdBarrier& b) {
    asm volatile("s_waitcnt vmcnt(0)" ::: "memory");
    __syncthreads();
    if (threadIdx.x == 0) {
        unsigned* bar = b.bar;
        __builtin_amdgcn_s_waitcnt(0);
        unsigned nloc = b.st[0], nx = b.st[1];
        if (nloc == 0u) { xcd_barrier_complete(bar, b.x, nloc, nx); b.st[0] = nloc; b.st[1] = nx; }
        const unsigned old = xb_add(&bar[XB_XSUB(b.x)], 1u);
        const unsigned gen = old / nloc;
        if (old + 1u == (gen + 1u) * nloc) {
            __builtin_amdgcn_fence(__ATOMIC_RELEASE, "agent");
            asm volatile("s_waitcnt vmcnt(0)" ::: "memory");
            const unsigned og = xb_add(&bar[XB_TOP], 1u);
            const unsigned tg = og / nx;
            if (og + 1u == (tg + 1u) * nx) xb_add(&bar[XB_TOPGEN], 1u);
            else XB_SPIN(xb_ld(&bar[XB_TOPGEN]) == tg, bar);
            __builtin_amdgcn_fence(__ATOMIC_ACQUIRE, "agent");
            xb_add(&bar[XB_XGEN(b.x)], 1u);
            asm volatile("s_waitcnt vmcnt(0)" ::: "memory");
        } else {
            XB_SPIN(xb_ld(&bar[XB_XGEN(b.x)]) == gen, bar);
            __builtin_amdgcn_fence(__ATOMIC_ACQUIRE, "agent");
            asm volatile("s_waitcnt vmcnt(0)" ::: "memory");
        }
    }
    __syncthreads();
}

__device__ __forceinline__ void publish_cnt(unsigned* c) {
    asm volatile("s_waitcnt vmcnt(0)" ::: "memory");
    __syncthreads();
    if (threadIdx.x == 0) (void)xb_add(c, 1u);
}
__device__ __forceinline__ void wait_cnt(unsigned* c, unsigned target) {
    if (threadIdx.x == 0) {
        unsigned sp = 0u; while (xb_ld(c) < target) { __builtin_amdgcn_s_sleep(4); if (++sp > (1u << 24)) break; }
        __builtin_amdgcn_fence(__ATOMIC_ACQUIRE, "agent"); asm volatile("s_waitcnt vmcnt(0)" ::: "memory");
    }
    __syncthreads();
}
struct OneUnit { pg8::Unit u; __device__ __forceinline__ bool next(int i, pg8::Unit& o) const { if (i) return false; o = u; return true; } };
constexpr int CW_DEP = 8192;

#ifndef PH
#define PH 0xff
#endif
#ifndef REP_GEMM
#define REP_GEMM 1
#endif
#ifndef REP_MIX
#define REP_MIX 1
#endif
#define GRID_SYNC() do { XcdBarrier xb_; xb_.bar = ctl + 4096; xb_.x = (unsigned)__builtin_amdgcn_readfirstlane((int)xbar_x); xb_.st = (volatile LAS unsigned*)(ldsl + RING_BYTES + 2048); xcd_barrier(xb_); } while (0)

__device__ __forceinline__ unsigned f2bf(float f) { unsigned u = __builtin_bit_cast(unsigned, f); return (u + 0x7fffu + ((u >> 16) & 1u)) >> 16; }
__device__ __forceinline__ unsigned pk2(float lo, float hi) { return f2bf(lo) | (f2bf(hi) << 16); }
__device__ __forceinline__ void transpose_item(const float* W, int N, int srccol, const float* kscale, bf16_t* WT, int K, int dstrow, int k0, LAS float* scr, int lane) {
    f32x4 t[8];
#pragma unroll
    for (int i = 0; i < 8; ++i) t[i] = __builtin_nontemporal_load((const f32x4*)(W + (size_t)(k0 + 8 * i + (lane >> 3)) * N + srccol + 4 * (lane & 7)));
#pragma unroll
    for (int i = 0; i < 8; ++i) { const int kk = 8 * i + (lane >> 3); f32x4 v = t[i]; if (kscale) v = v * kscale[k0 + kk];
        LAS float* d = scr + kk * 33 + 4 * (lane & 7); d[0] = v[0]; d[1] = v[1]; d[2] = v[2]; d[3] = v[3]; }
    asm volatile("s_waitcnt lgkmcnt(0)" ::: "memory");
    const int c = lane & 7;
#pragma unroll
    for (int j = 0; j < 4; ++j) { const int n = (lane >> 3) + 8 * j; const LAS float* s = scr + (8 * c) * 33 + n;
        u32x4 o; o.x = pk2(s[0 * 33], s[1 * 33]); o.y = pk2(s[2 * 33], s[3 * 33]); o.z = pk2(s[4 * 33], s[5 * 33]); o.w = pk2(s[6 * 33], s[7 * 33]);
        *(u32x4*)(WT + (size_t)(dstrow + n) * K + k0 + 8 * c) = o; }
    asm volatile("s_waitcnt lgkmcnt(0)" ::: "memory");
}
__device__ __forceinline__ int win_srccol(int gd) {
    if (gd < 16) { const int pn = gd >> 3, j = gd & 7, bj = j >> 2, wc = j & 3, head = 4 * pn + wc; return (head < 6 ? 1664 + 64 * head : 2048 + 64 * (head - 6)) + 32 * bj; }
    if (gd < 32) return 1152 + 32 * (gd - 16);
    if (gd < 44) return 32 * (gd - 32);
    if (gd < 56) return 384 + 32 * (gd - 44);
    if (gd < 68) return 768 + 32 * (gd - 56);
    return 2176 + 32 * (gd - 68);
}

constexpr int CV_IN = 16 * 72, CV_O = 16 * 32, CV_F1 = 16 * 176, CV_F2 = 44 * 32, CV_L = CV_IN + CV_O + CV_F1 + CV_F2;
__device__ __forceinline__ void conv_item(const Params& P, int l, int r, LAS float* scr, int lane) {
    unsigned char* wsb = P.ws;
    bf16_t* Win_ = (bf16_t*)(wsb + WS_WIN); bf16_t* Wo_ = (bf16_t*)(wsb + WS_WO); bf16_t* Wf1_ = (bf16_t*)(wsb + WS_WF1); bf16_t* Wf2_ = (bf16_t*)(wsb + WS_WF2);
    if (r < CV_IN) { const int kb = r / 72, gd = r % 72; transpose_item(P.w_in + (size_t)l * DM * DIN, DIN, win_srccol(gd), nullptr, Win_ + (size_t)l * DIN * DM, DM, 32 * gd, 64 * kb, scr, lane); return; } r -= CV_IN;
    if (r < CV_O) { const int kb = r / 32, gd = r % 32; transpose_item(P.w_o + (size_t)l * DM * DM, DM, 32 * gd, P.g_out + l * DM, Wo_ + (size_t)l * DM * DM, DM, 32 * gd, 64 * kb, scr, lane); return; } r -= CV_O;
    if (r < CV_F1) { const int kb = r / 176, gd = r % 176; const int pn = gd >> 3, j = gd & 7, bj = j >> 2, wc = j & 3;
        transpose_item(P.w_ffn_in + (size_t)l * DM * 2 * DFF, 2 * DFF, bj * DFF + 128 * pn + 32 * wc, nullptr, Wf1_ + (size_t)l * 2 * DFF * DM, DM, 32 * gd, 64 * kb, scr, lane); return; } r -= CV_F1;
    { const int kb = r / 32, gd = r % 32; transpose_item(P.w_ffn_out + (size_t)l * DFF * DM, DM, 32 * gd, nullptr, Wf2_ + (size_t)l * DM * DFF, DFF, 32 * gd, 64 * kb, scr, lane); }
}

__device__ __forceinline__ void wave_sum2(float& a, float& b) {
#pragma unroll
    for (int o = 1; o < 64; o <<= 1) { const float ta = __shfl_xor(a, o), tb = __shfl_xor(b, o); a += ta; b += tb; }
}
__device__ __forceinline__ void row_pass(const Params& P, int l, int mode, LAS float* pl) {
    const int tid_ = opaque_tid(), lane = tid_ & 63; const int NGW = gridDim.x * NWAVES, gw = blockIdx.x * NWAVES + __builtin_amdgcn_readfirstlane(tid_ >> 6);
    unsigned char* ws = P.ws;
    float* xres = (float*)(ws + WS_XRES); const bf16_t* Y = (const bf16_t*)(ws + WS_Y); bf16_t* H = (bf16_t*)(ws + WS_H);
    const float* mod = (const float*)(ws + WS_MOD); float* ssb = (float*)(ws + WS_SS); const float* y32 = (const float*)(ws + WS_Y32);
    const bool lastl = (l == DEPTH - 1);
    const bool latent_only = lastl && mode != 0;
    const int nrows = latent_only ? BATCH * SEQ : MROWS;
    const int gidx = (mode == 1) ? 2 : 5;
    const int ml = (mode == 2) ? l + 1 : l;
    const int shi = (mode == 1) ? 3 : 0;
    const bool make_h = !(lastl && mode == 2);
    const bool from_in = (mode == 0) || (mode == 1 && l == 0);
    const float* lg = (mode == 1) ? P.ln1_g + l * DM : P.ln2_g + l * DM;
    const float* lb = (mode == 1) ? P.ln1_b + l * DM : P.ln2_b + l * DM;
    { const int t_ = opaque_tid();
      for (int i = t_; i < 3 * DM; i += NTHREADS) { const int mvi = i >> 10, c = i & 1023;
          if (mode != 0) pl[i] = mod[(size_t)(l * 3 + mvi) * NMOD + gidx * DM + c];
          if (make_h) { pl[5120 + i] = mod[(size_t)(ml * 3 + mvi) * NMOD + shi * DM + c]; pl[8192 + i] = mod[(size_t)(ml * 3 + mvi) * NMOD + (shi + 1) * DM + c] + 1.0f; } }
      if (mode != 0) for (int i = t_; i < DM; i += NTHREADS) { pl[3072 + i] = lg[i]; pl[4096 + i] = lb[i]; }
      asm volatile("s_waitcnt lgkmcnt(0)" ::: "memory"); __syncthreads(); }
    f32x4 nx[2][4]; u32x2 ny[2][4];
#define RP_ISSUE(kq) do { _Pragma("unroll") for (int r = 0; r < 2; ++r) { \
        const int i_ = (kq) + r * NGW; const int ii_ = (i_ < nrows) ? i_ : (kq); \
        int b_, w_; if (latent_only) { b_ = ii_ / SEQ; w_ = ii_ % SEQ; } else { const int ir_ = (ii_ + 1536) % MROWS; b_ = ir_ / RPB; w_ = ir_ % RPB; } \
        const bool lat_ = w_ < SEQ; const int row_ = b_ * RPB + w_; \
        const float* src_ = from_in ? (lat_ ? P.x + ((size_t)b_ * SEQ + w_) * DM : P.ctx + ((size_t)b_ * CTXL + (w_ - SEQ)) * DM) : xres + (size_t)row_ * DM; \
        _Pragma("unroll") for (int j = 0; j < 4; ++j) nx[r][j] = __builtin_nontemporal_load((const f32x4*)(src_ + 4 * lane + 256 * j)); \
        if (mode != 0 && lat_) { _Pragma("unroll") for (int j = 0; j < 4; ++j) ny[r][j] = __builtin_nontemporal_load((const u32x2*)(Y + (size_t)row_ * DM + 4 * lane + 256 * j)); } } } while (0)
    if (gw < nrows) RP_ISSUE(gw);
    for (int i0 = gw; i0 < nrows; i0 += 2 * NGW) {
        f32x4 v[2][4], yv[2][4]; u32x2 yr[2][4]; int row[2], mv[2]; bool ok[2]; float* dst[2];
#pragma unroll
        for (int r = 0; r < 2; ++r)
#pragma unroll
            for (int j = 0; j < 4; ++j) { v[r][j] = nx[r][j]; yr[r][j] = ny[r][j]; }
        if (i0 + 2 * NGW < nrows) RP_ISSUE(i0 + 2 * NGW);
        __builtin_amdgcn_sched_barrier(0);
#pragma unroll
        for (int r = 0; r < 2; ++r) {
            const int i = i0 + r * NGW; ok[r] = i < nrows; const int ii = ok[r] ? i : i0;
            int b, w; if (latent_only) { b = ii / SEQ; w = ii % SEQ; } else { const int ir = (ii + 1536) % MROWS; b = ir / RPB; w = ir % RPB; }
            row[r] = b * RPB + w; const bool lat = w < SEQ; mv[r] = lat ? b : 2;
            dst[r] = (lastl && mode == 2) ? P.out + (size_t)ii * DM : xres + (size_t)row[r] * DM;
            if (mode != 0) {
                if (lat) {
#pragma unroll
                    for (int j = 0; j < 4; ++j) { const u32x2 yy = yr[r][j];
                        yv[r][j][0] = __uint_as_float(yy.x << 16); yv[r][j][1] = __uint_as_float(yy.x & 0xffff0000u); yv[r][j][2] = __uint_as_float(yy.y << 16); yv[r][j][3] = __uint_as_float(yy.y & 0xffff0000u); }
                } else {
                    const int nsl = (mode == 1) ? 3 : 11;
#pragma unroll
                    for (int j = 0; j < 4; ++j) { const float* yq = y32 + (size_t)(b * CTXL + (w - SEQ)) * DM + 4 * lane + 256 * j; f32x4 a = *(const f32x4*)yq;
                        for (int sl = 1; sl < nsl; ++sl) a = a + *(const f32x4*)(yq + (size_t)sl * 512 * DM);
                        yv[r][j] = a; }
                }
            }
        }
        if (mode != 0) {
            float s[2], q[2];
#pragma unroll
            for (int r = 0; r < 2; ++r) { const LAS float* gm = pl + mv[r] * DM; s[r] = 0.f; q[r] = 0.f;
#pragma unroll
                for (int j = 0; j < 4; ++j) { const f32x4 g = *(const LAS f32x4*)(gm + 4 * lane + 256 * j); v[r][j] = v[r][j] * ALPHA + g * yv[r][j];
                    s[r] += (v[r][j][0] + v[r][j][1]) + (v[r][j][2] + v[r][j][3]); const f32x4 sq = v[r][j] * v[r][j]; q[r] += (sq[0] + sq[1]) + (sq[2] + sq[3]); } }
            wave_sum2(s[0], s[1]); wave_sum2(q[0], q[1]);
#pragma unroll
            for (int r = 0; r < 2; ++r) { const float mean = s[r] * (1.f / DM); const float var = fmaxf(q[r] * (1.f / DM) - mean * mean, 0.f); const float rstd = 1.f / sqrtf(var + LN_EPS);
#pragma unroll
                for (int j = 0; j < 4; ++j) { const f32x4 g = *(const LAS f32x4*)(pl + 3072 + 4 * lane + 256 * j), bb = *(const LAS f32x4*)(pl + 4096 + 4 * lane + 256 * j); v[r][j] = (v[r][j] - mean) * rstd * g + bb; } }
        }
        if (mode != 0) {
#pragma unroll
        for (int r = 0; r < 2; ++r) if (ok[r]) {
#pragma unroll
            for (int j = 0; j < 4; ++j) __builtin_nontemporal_store(v[r][j], (f32x4*)(dst[r] + 4 * lane + 256 * j)); } }
        if (make_h) {
            float s[2], q[2];
#pragma unroll
            for (int r = 0; r < 2; ++r) { s[r] = 0.f; q[r] = 0.f;
#pragma unroll
                for (int j = 0; j < 4; ++j) { s[r] += (v[r][j][0] + v[r][j][1]) + (v[r][j][2] + v[r][j][3]); const f32x4 sq = v[r][j] * v[r][j]; q[r] += (sq[0] + sq[1]) + (sq[2] + sq[3]); } }
            wave_sum2(s[0], s[1]); wave_sum2(q[0], q[1]);
#pragma unroll
            for (int r = 0; r < 2; ++r) if (ok[r]) { const float mean = s[r] * (1.f / DM); const float var = fmaxf(q[r] * (1.f / DM) - mean * mean, 0.f); const float rstd = 1.f / sqrtf(var + LN_EPS);
                const LAS float* mm = pl + 5120 + mv[r] * DM;
#pragma unroll
                for (int j = 0; j < 4; ++j) { const f32x4 sh = *(const LAS f32x4*)(mm + 4 * lane + 256 * j), sc1 = *(const LAS f32x4*)(mm + 3072 + 4 * lane + 256 * j);
                    const f32x4 hv = (v[r][j] - mean) * rstd * sc1 + sh; u32x2 o; o.x = cvt_pk_bf16(hv[0], hv[1]); o.y = cvt_pk_bf16(hv[2], hv[3]);
                    __builtin_nontemporal_store(o, (u32x2*)(H + (size_t)row[r] * DM + 4 * lane + 256 * j)); } }
        }
        if (mode != 1 && lane == 0) {
#pragma unroll
            for (int r = 0; r < 2; ++r) if (ok[r]) { float z_; asm volatile("v_mov_b32 %0, 0" : "=v"(z_)); *(f32x4*)(ssb + (size_t)row[r] * 4) = (f32x4){z_, z_, z_, z_}; } }
    }
}

#undef RP_ISSUE
constexpr int SG_VT = 0, SG_VT_PITCH = 136, SG_STAGE = 73728;
__device__ __forceinline__ void sg_unit(const Params& P, int l, int chunk, char* shm, float* ssb) {
    const int tid_ = opaque_tid(), lane = tid_ & 63, wid = __builtin_amdgcn_readfirstlane(tid_ >> 6);
    unsigned char* ws = P.ws;
    const bf16_t* qkv = (const bf16_t*)(ws + WS_QKV); bf16_t* omix = (bf16_t*)(ws + WS_OMIX);
    const bf16_t* Wsb = (const bf16_t*)(ws + WS_WS) + (size_t)l * 4 * 128 * 128;
    const int R0 = chunk * 128;
    bf16_t* vt = (bf16_t*)(shm + SG_VT);
    const float* gs = P.g_sgu + l * 256;
    const f32x4 g4 = *(const f32x4*)(gs + 4 * lane);
    for (int q = wid * 16; q < wid * 16 + 16; ++q) {
        const u32x2 vv = *(const u32x2*)(qkv + (size_t)(R0 + q) * DIN + C_V + 4 * lane);
        f32x4 v; v[0] = __uint_as_float(vv.x << 16); v[1] = __uint_as_float(vv.x & 0xffff0000u); v[2] = __uint_as_float(vv.y << 16); v[3] = __uint_as_float(vv.y & 0xffff0000u);
        const float mean = wave_sum((v[0] + v[1]) + (v[2] + v[3])) * (1.f / 256.f);
        v = v - mean; const f32x4 sq = v * v;
        const float rstd = 1.f / sqrtf(wave_sum((sq[0] + sq[1]) + (sq[2] + sq[3])) * (1.f / 256.f) + LN_EPS);
        v = v * rstd * g4;
#pragma unroll
        for (int j = 0; j < 4; ++j) vt[(4 * lane + j) * SG_VT_PITCH + q] = (bf16_t)(at::cvtpk_s(v[j], 0.f) & 0xffffu);
    }
    asm volatile("s_waitcnt lgkmcnt(0)\n\ts_barrier" ::: "memory");
    const int g = wid >> 1, ph = wid & 1, r32 = lane & 31, hi = lane >> 5;
    f32x16 acc[2][2];
#pragma unroll
    for (int a = 0; a < 2; ++a)
#pragma unroll
        for (int b = 0; b < 2; ++b) acc[a][b] = f32x16{};
    const bf16_t* Wg = Wsb + (size_t)g * 128 * 128;
#pragma unroll
    for (int k0 = 0; k0 < 128; k0 += 16) {
        bf16x8 af[2], bfr[2];
#pragma unroll
        for (int pt = 0; pt < 2; ++pt) af[pt] = *(const bf16x8*)(Wg + (size_t)(64 * ph + 32 * pt + r32) * 128 + k0 + 8 * hi);
#pragma unroll
        for (int ct = 0; ct < 2; ++ct) bfr[ct] = *(const bf16x8*)(vt + (64 * g + 32 * ct + r32) * SG_VT_PITCH + k0 + 8 * hi);
#pragma unroll
        for (int pt = 0; pt < 2; ++pt)
#pragma unroll
            for (int ct = 0; ct < 2; ++ct) acc[pt][ct] = __builtin_amdgcn_mfma_f32_32x32x16_bf16(af[pt], bfr[ct], acc[pt][ct], 0, 0, 0);
    }
    const float* bs = P.b_s + (size_t)l * 512 + g * 128;
    float ones[16];
#pragma unroll
    for (int r = 0; r < 16; ++r) ones[r] = 1.0f;
#pragma unroll
    for (int pt = 0; pt < 2; ++pt) {
        f32x16 o[2];
#pragma unroll
        for (int r = 0; r < 16; ++r) { const int p = 64 * ph + 32 * pt + at::crow(r, hi); const float bp = bs[p];
#pragma unroll
            for (int ct = 0; ct < 2; ++ct) { const float uu = bf2f(qkv[(size_t)(R0 + p) * DIN + C_U + 64 * g + 32 * ct + r32]); o[ct][r] = uu * (acc[pt][ct][r] + bp); } }
        const int prow = R0 + 64 * ph + 32 * pt;
        at::store_tile(o, ones, (bf16_t*)(shm + SG_STAGE) + wid * 2048, omix + (size_t)prow * DM + 384 + 64 * g, DM, ssb + (size_t)prow * 4 + 1, lane, r32, hi);
    }
    asm volatile("s_waitcnt vmcnt(0) lgkmcnt(0)\n\ts_barrier" ::: "memory");
}

__global__ void __launch_bounds__(NTHREADS, 2) mega_fwd(Params P) {
    extern __shared__ __attribute__((aligned(16))) unsigned char lds[];
    cg::grid_group grid = cg::this_grid();
    LAS unsigned char* ldsl = (LAS unsigned char*)lds;
    const int G = gridDim.x, bx = blockIdx.x;
#define ws (opq(P.ws))
#define ctl ((unsigned*)(ws + WS_CTL))
#define mod ((float*)(ws + WS_MOD))
#define tcos ((float*)(ws + WS_ROPE))
#define tsin ((float*)(ws + WS_ROPE) + 128 * 16)
#define Win ((bf16_t*)(ws + WS_WIN))
#define Wo ((bf16_t*)(ws + WS_WO))
#define Wf1 ((bf16_t*)(ws + WS_WF1))
#define Wf2 ((bf16_t*)(ws + WS_WF2))
#define Hb ((bf16_t*)(ws + WS_H))
#define Yb ((bf16_t*)(ws + WS_Y))
#define qkv ((bf16_t*)(ws + WS_QKV))
#define omix ((bf16_t*)(ws + WS_OMIX))
#define hid ((bf16_t*)(ws + WS_HID))
#define ssb ((float*)(ws + WS_SS))
    { volatile LAS unsigned* st0 = (volatile LAS unsigned*)(ldsl + RING_BYTES + 2048); if (threadIdx.x < 2) st0[threadIdx.x] = 0u; __syncthreads(); }
    const unsigned xbar_x = xcd_barrier_post(ctl + 4096, (volatile LAS unsigned*)(ldsl + RING_BYTES + 2048)).x;

    if (PH & 1) {
        const int tid = opaque_tid(), lane = tid & 63, wid = __builtin_amdgcn_readfirstlane(tid >> 6);
        const int gw = bx * NWAVES + wid, NGW = G * NWAVES;
        LAS float* scv = (LAS float*)(ldsl + 69632);
        LAS float* red = (LAS float*)(ldsl + 69632 + 12288);
        for (int i = tid; i < 3 * DM; i += NTHREADS) { const int v = i / DM, k = i % DM; const float cv = (v < 2) ? P.c[v * DM + k] : P.c_ctx[k]; scv[i] = cv / (1.0f + __expf(-cv)); }
        __syncthreads();
        if (bx == 0 && wid == 0) { for (int l2 = 0; l2 < DEPTH; ++l2) { float a = fabsf(P.g_q[l2 * 64 + lane]), c2 = fabsf(P.g_k[l2 * 64 + lane]);
#pragma unroll
                for (int o_ = 1; o_ < 64; o_ <<= 1) { a = fmaxf(a, __shfl_xor(a, o_)); c2 = fmaxf(c2, __shfl_xor(c2, o_)); }
                if (lane == 0) tcos[4096 + l2] = fminf(8.0f * LOG2E * 1.02f * a * c2, 60.0f); } }
        for (int i = bx * NTHREADS + tid; i < 128 * 16; i += G * NTHREADS) { const int pos = i >> 4, f = i & 15;
            const float inv = exp2f(-(float)f * (13.287712379549449f / 16.0f)); const float ang = (float)pos * inv;
            tcos[i] = cosf(ang); tsin[i] = sinf(ang); }
        { bf16_t* Wsb = (bf16_t*)(ws + WS_WS); for (int i = bx * NTHREADS + tid; i < DEPTH * 4 * 128 * 128; i += G * NTHREADS) Wsb[i] = (bf16_t)f2bf(P.w_s[i]); }
        LAS float* scr = (LAS float*)(ldsl + wid * 8448);
        LAS int* qslot = (LAS int*)(ldsl + RING_BYTES + 1024);
        for (;;) {
            if (tid == 0) qslot[0] = (int)atomicAdd(ctl + 64 * 20, 1u);
            __syncthreads();
            const int qi = __builtin_amdgcn_readfirstlane(qslot[0]);
            __syncthreads();
            if (qi >= DEPTH * 24 + CV_L / 8) break;
            if (qi < DEPTH * 24) {
                const int l2 = qi / 24, cg4 = qi % 24, n4 = 256 * cg4 + 4 * lane;
                const float* W = P.w_mod + (size_t)l2 * DM * NMOD + n4;
                f32x4 a0 = {0.f, 0.f, 0.f, 0.f}, a1 = a0, a2 = a0;
#pragma unroll 8
                for (int kk = 0; kk < 128; ++kk) { const int k = wid * 128 + kk; const f32x4 wv = __builtin_nontemporal_load((const f32x4*)(W + (size_t)k * NMOD)); a0 += wv * scv[k]; a1 += wv * scv[DM + k]; a2 += wv * scv[2 * DM + k]; }
                LAS f32x4* red4 = (LAS f32x4*)red;
                red4[(wid * 3 + 0) * 64 + lane] = a0; red4[(wid * 3 + 1) * 64 + lane] = a1; red4[(wid * 3 + 2) * 64 + lane] = a2;
                __syncthreads();
                for (int o = tid; o < 768; o += NTHREADS) { const int v = o >> 8, col = o & 255; float sacc = P.b_mod[(size_t)l2 * NMOD + 256 * cg4 + col];
#pragma unroll
                    for (int w2 = 0; w2 < 8; ++w2) sacc += red[(w2 * 3 + v) * 256 + col];
                    mod[(size_t)(l2 * 3 + v) * NMOD + 256 * cg4 + col] = sacc; }
                __syncthreads();
            } else {
                conv_item(P, 0, (qi - DEPTH * 24) * 8 + wid, scr, lane);
            }
        }
    }
    if (G == 0x7fffffff) grid.sync();
    GRID_SYNC();
    if (PH & 2) row_pass(P, 0, 0, (LAS float*)ldsl);
    GRID_SYNC();

    for (int l = 0; l < DEPTH; ++l) {
        const bool lastl = (l == DEPTH - 1);
        if (PH & 4) { pg8::Gemm g{Hb, Win + (size_t)l * DIN * DM, MROWS, DIN, DM}; pg8::StaticOrder S; S.init(66, DIN, G, bx, 0, 16, 4);
          pg8::EpiQKV E{qkv, P.g_q + l * 64, P.g_k + l * 64, tcos, tsin};
          pg8::gemm_phase<pg8::EpiQKV, pg8::StaticOrder, true, true>(ldsl, g, S, E); }
        if (!lastl && bx >= 82) {
            const int t_ = opaque_tid(), w_ = __builtin_amdgcn_readfirstlane(t_ >> 6);
            for (int c = bx - 82; c < CV_L / 8; c += G - 82) conv_item(P, l + 1, c * 8 + w_, (LAS float*)(ldsl + w_ * 8448), t_ & 63);
        }
        GRID_SYNC();
        {
            LAS int* qslot = (LAS int*)(ldsl + RING_BYTES + 1024);
            const int n_gqa = 384, n_na = 384, n_sg = 132, n_cx = lastl ? 0 : 24;
            const int n_prod = n_gqa + n_na + n_sg + n_cx;
            const int ntot = n_prod + 256 + (lastl ? 0 : 24);
            unsigned* cw = ctl + CW_DEP + (size_t)l * 66 * 16;
            for (;;) {
                if (opaque_tid() == 0) qslot[0] = (int)atomicAdd(ctl + 64 * (l + 1), 1u);
                __syncthreads();
                const int idx = __builtin_amdgcn_readfirstlane(qslot[0]);
                __syncthreads();
                if (idx >= ntot) break;
                if (idx < n_gqa) {
                    const int qb = idx / 12, r12 = idx % 12, b = r12 / 6, h = r12 % 6; const size_t rb = (size_t)b * RPB;
                    ap::unit<8, 0>(qkv + (rb + 256 * qb) * DIN + C_QC + 64 * h, qkv + rb * DIN + C_KC + 64 * (h / 3), qkv + rb * DIN + C_VC + 64 * (h / 3),
                                   omix + (rb + 256 * qb) * DM + 640 + 64 * h, ssb + (rb + 256 * qb) * 4 + 2, 132, (char*)lds, 0, 0, tcos[4096 + l]);
                    publish_cnt(cw + (b * 33 + qb) * 16);
                } else if (idx < n_gqa + n_na) {
                    const int i2 = idx - n_gqa; const int rblk = i2 / 12, r12 = i2 % 12, b = r12 / 6, h = r12 % 6; const size_t rb = (size_t)b * RPB;
                    { float* bl = (float*)((char*)lds + ap::LDS_NABIAS); const float* src = P.rpb + ((size_t)l * 6 + h) * 465; for (int i = opaque_tid(); i < 465; i += NTHREADS) bl[i] = src[i] * LOG2E; }
                    __syncthreads();
                    const int r0 = 4 * rblk, klo = min(max(r0 - 4, 0), 120), khi = min(max(r0 - 1, 0), 120) + 7; const int nlt = (khi - klo + 2) & ~1;
                    ap::unit<8, 1>(qkv + (rb + 256 * rblk) * DIN + C_QA + 64 * h, qkv + rb * DIN + C_KA + 64 * h, qkv + rb * DIN + C_VA + 64 * h,
                                   omix + (rb + 256 * rblk) * DM + 64 * h, ssb + (rb + 256 * rblk) * 4 + 0, 4 + nlt, (char*)lds, klo, r0);
                    publish_cnt(cw + (b * 33 + rblk) * 16);
                } else if (idx < n_gqa + n_na + n_sg) {
                    const int ch = idx - n_gqa - n_na;
                    if (!(lastl && (ch % 66) >= 64)) { sg_unit(P, l, ch, (char*)lds, ssb); publish_cnt(cw + (ch >> 1) * 16); }
                } else if (idx < n_prod) {
                    const int i2 = idx - n_gqa - n_na - n_sg; const bool isna = i2 < 12; const int i3 = isna ? i2 : i2 - 12; const int b = i3 / 6, h = i3 % 6; const size_t rb = (size_t)b * RPB + SEQ;
                    at::Job J; J.Q = qkv + rb * DIN + (isna ? C_QA : C_QC) + 64 * h;
                    J.Kc = qkv + rb * DIN + (isna ? C_KA + 64 * h : C_KC + 64 * (h / 3)); J.Vc = qkv + rb * DIN + (isna ? C_VA + 64 * h : C_VC + 64 * (h / 3));
                    J.Kl = J.Kc; J.Vl = J.Vc; J.O = omix + rb * DM + (isna ? 0 : 640) + 64 * h; J.ss = ssb + rb * 4 + (isna ? 0 : 2); J.nctx = 4; J.lt0 = 0; J.nlt = 0; J.r0 = 0;
                    at::unit<0>(J, (char*)lds);
                    publish_cnt(cw + (b * 33 + 32) * 16);
                } else {
                    const int j = idx - n_prod; OneUnit S1;
                    if (j < 256) { S1.u.pm = ((j >> 2) & 1) * 33 + (j >> 3); S1.u.pn = j & 3; S1.u.kt0 = 0; S1.u.nt = 16; }
                    else { const int jj = j - 256, tile = jj / 3, sl = jj % 3; S1.u.pm = (tile >> 2) ? 65 : 32; S1.u.pn = tile & 3; S1.u.kt0 = (sl == 0) ? 0 : (sl == 1 ? 6 : 10); S1.u.nt = (sl == 1) ? 4 : 6; }
                    wait_cnt(cw + S1.u.pm * 16, 14u);
                    LAS float* ft = (LAS float*)(ldsl + RING_BYTES + 4096);
                    if (j < 256) { const int t_ = opaque_tid(); if (t_ < 256) { const f32x4 s4 = *(const f32x4*)(ssb + (size_t)(S1.u.pm * 256 + t_) * 4);
                            const float ra = 1.0f / sqrtf(s4[0] * (1.0f / 384.0f) + LN_EPS), rb = 1.0f / sqrtf(s4[1] * (1.0f / 256.0f) + LN_EPS), rc = 1.0f / sqrtf(s4[2] * (1.0f / 384.0f) + LN_EPS);
                            ft[t_ * 4 + 0] = ra / rb; ft[t_ * 4 + 1] = rb / rc; ft[t_ * 4 + 2] = rc; }
                        __syncthreads(); }
                    pg8::Gemm g{omix, Wo + (size_t)l * DM * DM, MROWS, DM, DM};
                    pg8::EpiY<true> E{Yb, ssb, (float*)(ws + WS_Y32), 16, (j < 256) ? (const LAS float*)ft : (const LAS float*)nullptr};
                    pg8::gemm_phase<pg8::EpiY<true>, OneUnit, false, true>(ldsl, g, S1, E);
                }
            }
        }
        GRID_SYNC();
        if (PH & 2) row_pass(P, l, 1, (LAS float*)ldsl);
        GRID_SYNC();
        if (PH & 32) { pg8::Gemm g{Hb, Wf1 + (size_t)l * 2 * DFF * DM, MROWS, 2 * DFF, DM}; pg8::StaticOrder S; S.init(lastl ? 64 : 66, 2 * DFF, G, bx, lastl ? 1 : 0, 16);
          pg8::EpiSwiGLU E{hid};
          pg8::gemm_phase<pg8::EpiSwiGLU, pg8::StaticOrder, true, true>(ldsl, g, S, E); }
        GRID_SYNC();
        if (PH & 64) { pg8::Gemm g{hid, Wf2 + (size_t)l * DM * DFF, MROWS, DM, DFF}; pg8::StaticOrder S; S.init(64, DM, G, bx, 1, 44, lastl ? 0 : 2);
          pg8::EpiY<false> E{Yb, nullptr, (float*)(ws + WS_Y32), 44};
          pg8::gemm_phase<pg8::EpiY<false>, pg8::StaticOrder, true, true>(ldsl, g, S, E); }
        GRID_SYNC();
        if (PH & 2) row_pass(P, l, 2, (LAS float*)ldsl);
        if (!lastl) GRID_SYNC();
    }
}

#undef ws
#undef ctl
#undef mod
#undef tcos
#undef tsin
#undef Win
#undef Wo
#undef Wf1
#undef Wf2
#undef Hb
#undef Yb
#undef qkv
#undef omix
#undef hid
#undef ssb
extern "C" void kernel_launch(void* const* d_in, const int* in_sizes, int n_in, void* d_out, int out_size, void* d_ws, size_t ws_size, hipStream_t stream) {
    static int grid = 0;
    if (grid == 0) {
        if (n_in != 21 || ws_size < WS_TOTAL) { fprintf(stderr, "kernel_launch: need 21 inputs and %zu bytes of workspace; got %d, %zu\n", (size_t)WS_TOTAL, n_in, ws_size); grid = -1; return; }
        int dev = 0, cus = 0, per_cu = 0;
        hipGetDevice(&dev); hipDeviceGetAttribute(&cus, hipDeviceAttributeMultiprocessorCount, dev);
        if (hipFuncSetAttribute((const void*)mega_fwd, hipFuncAttributeMaxDynamicSharedMemorySize, LDS_BYTES) != hipSuccess) { fprintf(stderr, "kernel_launch: hipFuncSetAttribute failed\n"); grid = -1; return; }
        if (hipOccupancyMaxActiveBlocksPerMultiprocessor(&per_cu, (const void*)mega_fwd, NTHREADS, LDS_BYTES) != hipSuccess || per_cu < 1) { fprintf(stderr, "kernel_launch: occupancy query says %d\n", per_cu); per_cu = 1; }
        (void)hipGetLastError();
        grid = cus;
    }
    if (grid < 0) return;
    hipMemsetAsync((char*)d_ws + WS_CTL, 0, CTL_BYTES, stream);
    Params p{};
    const float** pp = (const float**)&p;
    for (int i = 0; i < 21; ++i) pp[i] = (const float*)d_in[i];
    p.out = (float*)d_out; p.ws = (unsigned char*)d_ws;
    void* args[] = {&p};
    hipError_t e = hipLaunchCooperativeKernel((const void*)mega_fwd, dim3(grid), dim3(NTHREADS), args, LDS_BYTES, stream);
    if (e != hipSuccess) fprintf(stderr, "cooperative launch failed: %s (grid %d)\n", hipGetErrorString(e), grid);
}
```

```cpp
#include <hip/hip_runtime.h>
#include <hip/hip_cooperative_groups.h>
#include <cstdio>
#include <cstdint>
#include <cmath>
namespace cg = cooperative_groups;

#define LAS __attribute__((address_space(3)))
typedef unsigned short bf16_t;
typedef short bf16x8 __attribute__((ext_vector_type(8)));
typedef float f32x4 __attribute__((ext_vector_type(4)));
typedef float f32x2 __attribute__((ext_vector_type(2)));
typedef float f32x16 __attribute__((ext_vector_type(16)));
typedef unsigned u32x4 __attribute__((ext_vector_type(4)));
typedef unsigned u32x2 __attribute__((ext_vector_type(2)));
typedef short s16x4 __attribute__((ext_vector_type(4)));

constexpr int DM = 1024, BATCH = 2, SEQ = 8192, DEPTH = 4, CTXL = 256;
constexpr int RPB = SEQ + CTXL;
constexpr int MROWS = BATCH * RPB;
constexpr int DIN = 2304, DFF = 2816, NMOD = 6 * DM;
constexpr int C_QC = 0, C_KC = 384, C_U = 512, C_V = 768, C_QA = 1024, C_KA = 1408, C_VA = 1792, C_VC = 2176;
constexpr float LN_EPS = 1e-6f;
constexpr float ALPHA = 1.681792830507429f;
constexpr float LOG2E = 1.4426950408889634f;
constexpr float C2 = 0.125f * LOG2E;

__device__ __forceinline__ unsigned char* opq(unsigned char* p) { asm volatile("" : "+s"(p)); return p; }
__device__ __forceinline__ int opaque_tid() { int t; asm volatile("v_mov_b32 %0, %1" : "=v"(t) : "v"((int)threadIdx.x)); return t; }
__device__ __forceinline__ unsigned cvt_pk_bf16(float lo, float hi) { unsigned r; asm volatile("v_cvt_pk_bf16_f32 %0, %1, %2" : "=v"(r) : "v"(lo), "v"(hi)); return r; }
__device__ __forceinline__ float bf2f(unsigned short h) { return __uint_as_float(((unsigned)h) << 16); }
__device__ __forceinline__ float wave_sum(float v) {
#pragma unroll
    for (int o = 1; o < 64; o <<= 1) v += __shfl_xor(v, o);
    return v;
}

__constant__ short qkv_order_tab[594] = {39, 111, 184, 256, 328, 400, 472, 558, 40, 112, 185, 257, 329, 401, 473, 559, 41, 113, 186, 258, 330, 402, 474, 560, 42, 114, 187, 259, 331, 403, 475, 561, 43, 115, 188, 260, 332, 404, 476, 562, 44, 116, 189, 261, 333, 405, 477, 563, 45, 117, 190, 262, 334, 406, 478, 564, 46, 118, 191, 263, 335, 407, 479, 565, 47, 119, 192, 264, 336, 408, 480, 566, 48, 120, 193, 265, 337, 409, 481, 567, 49, 121, 194, 266, 338, 410, 482, 568, 0, 75, 150, 224, 298, 372, 446, 576, 1, 76, 151, 225, 299, 373, 447, 577, 2, 77, 152, 226, 300, 374, 504, 578, 3, 78, 153, 227, 301, 375, 505, 579, 4, 79, 154, 228, 302, 432, 506, 520, 5, 80, 155, 229, 303, 433, 507, 521, 6, 81, 156, 230, 360, 434, 508, 522, 7, 82, 157, 231, 361, 435, 509, 523, 8, 83, 158, 288, 362, 436, 510, 524, 9, 84, 159, 289, 363, 437, 511, 525, 10, 85, 216, 290, 364, 438, 512, 526, 11, 86, 217, 291, 365, 439, 513, 527, 12, 87, 218, 292, 366, 440, 514, 528, 13, 144, 219, 293, 367, 441, 515, 529, 14, 145, 220, 294, 368, 442, 516, 530, 15, 146, 221, 295, 369, 443, 517, 531, 72, 147, 222, 296, 370, 444, 518, 532, 73, 148, 223, 297, 371, 445, 519, 533, 74, 149, 160, 232, 304, 376, 448, 534, 16, 88, 161, 233, 305, 377, 449, 535, 17, 89, 162, 234, 306, 378, 450, 536, 50, 122, 195, 267, 339, 411, 483, 569, 51, 123, 196, 268, 340, 412, 484, 570, 52, 124, 197, 269, 341, 413, 485, 571, 53, 125, 198, 270, 342, 414, 486, 572, 54, 126, 199, 271, 343, 415, 487, 573, 55, 127, 200, 272, 344, 416, 488, 574, 56, 128, 201, 273, 345, 417, 489, 575, 57, 129, 202, 274, 346, 418, 490, 580, 58, 130, 203, 275, 347, 419, 491, 581, 59, 131, 204, 276, 348, 420, 492, 582, 60, 132, 205, 277, 349, 421, 493, 583, 18, 90, 163, 235, 307, 379, 451, 537, 19, 91, 164, 236, 308, 380, 452, 538, 20, 92, 165, 237, 309, 381, 453, 539, 21, 93, 166, 238, 310, 382, 454, 540, 22, 94, 167, 239, 311, 383, 455, 541, 23, 95, 168, 240, 312, 384, 456, 542, 24, 96, 169, 241, 313, 385, 457, 543, 25, 97, 170, 242, 314, 386, 458, 544, 26, 98, 171, 243, 315, 387, 459, 545, 27, 99, 172, 244, 316, 388, 460, 546, 28, 100, 173, 245, 317, 389, 461, 547, 29, 101, 174, 246, 318, 390, 462, 548, 30, 102, 175, 247, 319, 391, 463, 549, 31, 103, 176, 248, 320, 392, 464, 550, 32, 104, 177, 249, 321, 393, 465, 551, 33, 105, 178, 250, 322, 394, 466, 552, 34, 106, 179, 251, 323, 395, 467, 553, 35, 107, 180, 252, 324, 396, 468, 554, 36, 108, 181, 253, 325, 397, 469, 555, 37, 109, 182, 254, 326, 398, 470, 556, 38, 110, 183, 255, 327, 399, 471, 557, 61, 133, 206, 278, 350, 422, 494, 584, 62, 134, 207, 279, 351, 423, 495, 585, 63, 135, 208, 280, 352, 424, 496, 586, 64, 136, 209, 281, 353, 425, 497, 587, 65, 137, 210, 282, 354, 426, 498, 588, 66, 138, 211, 283, 355, 427, 499, 589, 67, 139, 212, 284, 356, 428, 500, 590, 68, 140, 213, 285, 357, 429, 501, 591, 69, 141, 214, 286, 358, 430, 502, 592, 70, 142, 215, 287, 359, 431, 503, 593, 71, 143};
namespace pg8 {
constexpr int BM = 256, BK = 64, HALF = 128, HTB = HALF * BK * 2, STAGE_BYTES = 8 * HTB, NXCD = 8, WGM = 8;
__host__ __device__ __forceinline__ int lds_byte(int r, int c) { const int st = (r >> 4) * 2 + (c >> 5), rr = r & 15, cc = c & 31, ob = rr * 64 + cc * 2; return st * 1024 + (ob ^ (((ob >> 9) & 1) << 5)); }
__host__ __device__ __forceinline__ void stage_rc(int b, int& R, int& C) { const int st = b / 1024, sb = b % 1024, swz = sb ^ (((sb >> 9) & 1) << 5); R = (st >> 1) * 16 + swz / 64; C = (st & 1) * 32 + (swz % 64) / 2; }
__host__ __device__ __forceinline__ int perm32(int rho) { const int n = rho >> 4, i = rho & 15; return 8 * (i >> 2) + 4 * n + (i & 3); }

struct Unit { int pm, pn, kt0, nt; };
struct Gemm { const bf16_t* A; const bf16_t* Bt; int M, N, K; };

struct StaticOrder {
    int nM, nN, nwg, G, c, skipctx, ntK, xmode;
    __host__ __device__ void init(int nM_, int N, int G_, int c_, int skipctx_, int ntK_, int xmode_ = 0) { nM = nM_; nN = N / BM; nwg = nM * nN; G = G_; c = c_; skipctx = skipctx_; ntK = ntK_; xmode = xmode_; }
    __host__ __device__ bool next(int i, Unit& u) const {
        const long L = (long)i * G + c;
        if (L >= nwg) {
            if (xmode == 0 || xmode == 4) return false;
            const int rounds = (nwg + G - 1) / G; const int j = (int)((long)(i - rounds) * G + c);
            const int per = (xmode == 1) ? 3 : 11;
            if (i < rounds || j < 0 || j >= 8 * per) return false;
            const int tile = j / per, sl = j % per; u.pm = (tile >> 2) ? 65 : 32; u.pn = tile & 3;
            if (xmode == 1) { u.kt0 = (sl == 0) ? 0 : (sl == 1 ? 6 : 10); u.nt = (sl == 1) ? 4 : 6; } else { u.kt0 = 4 * sl; u.nt = 4; }
            return true;
        }
        int wgid = (int)L; { const int q = nwg / NXCD, r = nwg % NXCD, xcd = wgid % NXCD, off = wgid / NXCD; wgid = (xcd < r ? xcd * (q + 1) : r * (q + 1) + (xcd - r) * q) + off; }
#if defined(__HIP_DEVICE_COMPILE__)
        if (xmode == 4) wgid = qkv_order_tab[L];
#endif
        const int nig = WGM * nN, gid = wgid / nig, fm = gid * WGM, gsz = (nM - fm) < WGM ? (nM - fm) : WGM;
        u.pm = fm + ((wgid % nig) % gsz); u.pn = (wgid % nig) / gsz; u.kt0 = 0; u.nt = ntK;
        if (skipctx) u.pm += (u.pm >= 32) ? 1 : 0;
        return true;
    }
};

__device__ __forceinline__ float gelu_tanh(float v) {
    const float u = 0.7978845608028654f * (v + 0.044715f * v * v * v);
    return v * __builtin_amdgcn_rcpf(1.0f + __builtin_amdgcn_exp2f(-2.0f * LOG2E * u));
}
__device__ __forceinline__ float silu_f(float v) { return v * __builtin_amdgcn_rcpf(1.0f + __builtin_amdgcn_exp2f(-LOG2E * v)); }

struct EpiQKV {
    static constexpr bool PERM = true, AFTER_DRAIN = false, KSEG = false;
    bf16_t* O; const float* gq; const float* gk; const float* tcos; const float* tsin;
    __device__ __forceinline__ void kseg(f32x4 (&)[2][2][4][2], const Unit&, int, int, int) const {}
    __device__ __forceinline__ void operator()(const f32x4 (&acc)[2][2][4][2], const Unit& u, int wr, int wc, int fr, int fq) const {
        const int row0 = u.pm * BM + wr * 64 + fr;
        if (u.pn < 2) {
            const int head = 4 * u.pn + wc; const bool isq = head < 6;
            const float* g = isq ? gq : gk; const float gs = isq ? C2 : 1.0f;
            f32x4 gv[2][2];
#pragma unroll
            for (int bj = 0; bj < 2; ++bj)
#pragma unroll
                for (int n = 0; n < 2; ++n) gv[bj][n] = *(const f32x4*)(g + 32 * bj + 8 * fq + 4 * n) * gs;
            const int ocol = 64 * head + 8 * fq;
#pragma unroll
            for (int ai = 0; ai < 2; ++ai)
#pragma unroll
                for (int m = 0; m < 4; ++m) {
                    const int row = row0 + ai * HALF + m * 16;
                    const int w = row >= RPB ? row - RPB : row;
                    f32x4 x[2][2]; float ss = 0.f;
#pragma unroll
                    for (int bj = 0; bj < 2; ++bj)
#pragma unroll
                        for (int n = 0; n < 2; ++n) { x[bj][n] = acc[ai][bj][m][n]; const f32x4 q = x[bj][n] * x[bj][n]; ss += (q[0] + q[1]) + (q[2] + q[3]); }
                    ss += __shfl_xor(ss, 16); ss += __shfl_xor(ss, 32);
                    const float rinv = 1.0f / sqrtf(ss * (1.0f / 64.0f) + LN_EPS);
#pragma unroll
                    for (int bj = 0; bj < 2; ++bj)
#pragma unroll
                        for (int n = 0; n < 2; ++n) x[bj][n] = x[bj][n] * rinv * gv[bj][n];
                    if (w < SEQ) {
#pragma unroll
                        for (int bj = 0; bj < 2; ++bj) {
                            const int pos = bj ? (w & 63) : (w >> 6);
#pragma unroll
                            for (int n = 0; n < 2; ++n) {
                                const f32x4 cs = *(const f32x4*)(tcos + pos * 16 + 8 * (fq & 1) + 4 * n);
                                const f32x4 sn = *(const f32x4*)(tsin + pos * 16 + 8 * (fq & 1) + 4 * n);
                                f32x4 p; p[0] = __shfl_xor(x[bj][n][0], 32); p[1] = __shfl_xor(x[bj][n][1], 32); p[2] = __shfl_xor(x[bj][n][2], 32); p[3] = __shfl_xor(x[bj][n][3], 32);
                                const f32x4 sgn = (fq < 2) ? -sn : sn;
                                x[bj][n] = x[bj][n] * cs + p * sgn;
                            }
                        }
                    }
                    bf16_t* rowp = O + (size_t)row * DIN + ocol;
#pragma unroll
                    for (int bj = 0; bj < 2; ++bj) { u32x4 wv; wv.x = cvt_pk_bf16(x[bj][0][0], x[bj][0][1]); wv.y = cvt_pk_bf16(x[bj][0][2], x[bj][0][3]); wv.z = cvt_pk_bf16(x[bj][1][0], x[bj][1][1]); wv.w = cvt_pk_bf16(x[bj][1][2], x[bj][1][3]);
                        *(u32x4*)(rowp + 32 * bj) = wv; }
                }
        } else {
            const bool isg = u.pn < 4;
            const int col0 = u.pn * BM + wc * 32 + 8 * fq;
#pragma unroll
            for (int ai = 0; ai < 2; ++ai)
#pragma unroll
                for (int m = 0; m < 4; ++m) { bf16_t* rowp = O + (size_t)(row0 + ai * HALF + m * 16) * DIN + col0;
#pragma unroll
                    for (int bj = 0; bj < 2; ++bj) { f32x4 v0 = acc[ai][bj][m][0], v1 = acc[ai][bj][m][1];
                        if (isg) {
#pragma unroll
                            for (int j = 0; j < 4; ++j) { v0[j] = gelu_tanh(v0[j]); v1[j] = gelu_tanh(v1[j]); }
                        } else { const float sc = (u.pn * BM + bj * HALF < C_KA) ? C2 : 1.0f; v0 = v0 * sc; v1 = v1 * sc; }
                        u32x4 wv; wv.x = cvt_pk_bf16(v0[0], v0[1]); wv.y = cvt_pk_bf16(v0[2], v0[3]); wv.z = cvt_pk_bf16(v1[0], v1[1]); wv.w = cvt_pk_bf16(v1[2], v1[3]);
                        *(u32x4*)(rowp + bj * HALF) = wv; } }
        }
    }
};

struct EpiSwiGLU {
    static constexpr bool PERM = true, AFTER_DRAIN = false, KSEG = false;
    bf16_t* O;
    __device__ __forceinline__ void kseg(f32x4 (&)[2][2][4][2], const Unit&, int, int, int) const {}
    __device__ __forceinline__ void operator()(const f32x4 (&acc)[2][2][4][2], const Unit& u, int wr, int wc, int fr, int fq) const {
        const int row0 = u.pm * BM + wr * 64 + fr; const int col0 = u.pn * HALF + wc * 32 + 8 * fq;
#pragma unroll
        for (int ai = 0; ai < 2; ++ai)
#pragma unroll
            for (int m = 0; m < 4; ++m) { bf16_t* rowp = O + (size_t)(row0 + ai * HALF + m * 16) * DFF + col0;
                f32x4 v0, v1;
#pragma unroll
                for (int j = 0; j < 4; ++j) { v0[j] = silu_f(acc[ai][0][m][0][j]) * acc[ai][1][m][0][j]; v1[j] = silu_f(acc[ai][0][m][1][j]) * acc[ai][1][m][1][j]; }
                u32x4 wv; wv.x = cvt_pk_bf16(v0[0], v0[1]); wv.y = cvt_pk_bf16(v0[2], v0[3]); wv.z = cvt_pk_bf16(v1[0], v1[1]); wv.w = cvt_pk_bf16(v1[2], v1[3]);
                *(u32x4*)rowp = wv; }
    }
};

template <bool SEG> struct EpiY {
    static constexpr bool PERM = true, AFTER_DRAIN = false, KSEG = SEG;
    bf16_t* O; const float* ss; float* y32; int ntfull; const LAS float* ftab = nullptr;
    __device__ __forceinline__ void kseg(f32x4 (&acc)[2][2][4][2], const Unit& u, int t, int wr, int fr) const {
        if (ftab) {
#pragma unroll
            for (int ai = 0; ai < 2; ++ai)
#pragma unroll
                for (int m = 0; m < 4; ++m) { const float f = ftab[(ai * HALF + wr * 64 + m * 16 + fr) * 4 + (t == 6 ? 0 : 1)];
#pragma unroll
                    for (int bj = 0; bj < 2; ++bj)
#pragma unroll
                        for (int n = 0; n < 2; ++n) acc[ai][bj][m][n] = acc[ai][bj][m][n] * f; }
            return;
        }
        const float* sp = ss + (size_t)(u.pm * BM + wr * 64 + fr) * 4 + (t == 6 ? 0 : 1);
        const float n0 = (t == 6) ? (1.0f / 384.0f) : (1.0f / 256.0f), n1 = (t == 6) ? (1.0f / 256.0f) : (1.0f / 384.0f);
#pragma unroll
        for (int ai = 0; ai < 2; ++ai)
#pragma unroll
            for (int m = 0; m < 4; ++m) { const float* q = sp + (size_t)(ai * HALF + m * 16) * 4; const float s0 = q[0], s1 = q[1];
                const float f = sqrtf((s1 * n1 + LN_EPS) / (s0 * n0 + LN_EPS));
#pragma unroll
                for (int bj = 0; bj < 2; ++bj)
#pragma unroll
                    for (int n = 0; n < 2; ++n) acc[ai][bj][m][n] = acc[ai][bj][m][n] * f;
                asm volatile("" ::: "memory"); }
    }
    __device__ __forceinline__ void operator()(const f32x4 (&acc)[2][2][4][2], const Unit& u, int wr, int wc, int fr, int fq) const {
        const int row0 = u.pm * BM + wr * 64 + fr; const int col0 = u.pn * BM + wc * 32 + 8 * fq;
        if (u.nt != ntfull) {
            const int seg = (u.kt0 == 0) ? 0 : (u.kt0 == 6 ? 1 : 2); const float nn = (seg == 1) ? (1.0f / 256.0f) : (1.0f / 384.0f);
            const int crow0 = (u.pm == 32 ? 0 : 256) + wr * 64 + fr; const int slice = SEG ? seg : (u.kt0 >> 2);
#pragma unroll
            for (int ai = 0; ai < 2; ++ai)
#pragma unroll
                for (int m = 0; m < 4; ++m) { const int row = row0 + ai * HALF + m * 16; float* yp = y32 + ((size_t)slice * 512 + crow0 + ai * HALF + m * 16) * DM + col0;
                    float sc = 1.0f; if (SEG) sc = 1.0f / sqrtf(ss[(size_t)row * 4 + seg] * nn + LN_EPS);
#pragma unroll
                    for (int bj = 0; bj < 2; ++bj)
#pragma unroll
                        for (int n = 0; n < 2; ++n) *(f32x4*)(yp + bj * HALF + 4 * n) = acc[ai][bj][m][n] * sc; }
            return;
        }
#pragma unroll
        for (int ai = 0; ai < 2; ++ai)
#pragma unroll
            for (int m = 0; m < 4; ++m) { const int row = row0 + ai * HALF + m * 16; bf16_t* rowp = O + (size_t)row * DM + col0;
                float sc = 1.0f; if (SEG) { if (ftab) sc = ftab[(ai * HALF + wr * 64 + m * 16 + fr) * 4 + 2];
                    else { const float s2 = ss[(size_t)row * 4 + 2]; sc = 1.0f / sqrtf(s2 * (1.0f / 384.0f) + LN_EPS); } }
#pragma unroll
                for (int bj = 0; bj < 2; ++bj) { const f32x4 v0 = acc[ai][bj][m][0] * sc, v1 = acc[ai][bj][m][1] * sc;
                    u32x4 wv; wv.x = cvt_pk_bf16(v0[0], v0[1]); wv.y = cvt_pk_bf16(v0[2], v0[3]); wv.z = cvt_pk_bf16(v1[0], v1[1]); wv.w = cvt_pk_bf16(v1[2], v1[3]);
                    *(u32x4*)(rowp + bj * HALF) = wv; } }
    }
};

template <class Epi, class Sched, bool ALIGN_EPI = false, bool SP2 = false>
__device__ __forceinline__ void gemm_phase(LAS unsigned char* lds, const Gemm g, const Sched& S, const Epi& E) {
    const int tid = opaque_tid(), wid = __builtin_amdgcn_readfirstlane(tid >> 6), lane = tid & 63, wr = wid >> 2, wc = wid & 3, fr = lane & 15, fq = lane >> 4;
    const int K = g.K;
    unsigned voffA[2], voffB[2];
#pragma unroll
    for (int i = 0; i < 2; ++i) { int R, C; stage_rc(tid * 16 + i * 8192, R, C); const int Rb = Epi::PERM ? ((R & ~31) + perm32(R & 31)) : R;
        voffA[i] = (unsigned)(R * K + C) * 2u; voffB[i] = (unsigned)(Rb * K + C) * 2u; }
    const size_t kstep = (size_t)(BK * 2);
    const size_t hstep = (size_t)HALF * K * 2;
    const size_t tstep = 2 * hstep;
    const unsigned ldsw = (unsigned)wid * 1024u;
    const int aoff = lds_byte(wr * 64 + fr, fq * 8), boff = lds_byte(wc * 32 + fr, fq * 8);
#define PG8_SA(b, h) (((b) * 2 + (h)) * HTB)
#define PG8_SB(b, h) ((4 + (b) * 2 + (h)) * HTB)
#define PG8_STAGE(bufoff, gbase, voff) do { _Pragma("unroll") for (int _i = 0; _i < 2; ++_i) \
        __builtin_amdgcn_global_load_lds((const unsigned*)((const char*)(gbase) + (voff)[_i]), (LAS unsigned*)(lds + (bufoff) + ldsw + _i * 8192), 16, 0, 0); } while (0)
#define PG8_LDA(dst, b, h) do { _Pragma("unroll") for (int m = 0; m < 4; ++m) _Pragma("unroll") for (int k = 0; k < 2; ++k) dst[m][k] = *(const LAS bf16x8*)(lds + PG8_SA(b, h) + aoff + m * 2048 + k * 1024); } while (0)
#define PG8_LDB(dst, b, h) do { _Pragma("unroll") for (int n = 0; n < 2; ++n) _Pragma("unroll") for (int k = 0; k < 2; ++k) dst[n][k] = *(const LAS bf16x8*)(lds + PG8_SB(b, h) + boff + n * 2048 + k * 1024); } while (0)
#define PG8_MMA(ai, bj, At, Bt) do { __builtin_amdgcn_s_setprio(1); _Pragma("unroll") for (int m = 0; m < 4; ++m) _Pragma("unroll") for (int n = 0; n < 2; ++n) _Pragma("unroll") for (int k = 0; k < 2; ++k) \
        acc[ai][bj][m][n] = __builtin_amdgcn_mfma_f32_16x16x32_bf16(Bt[n][k], At[m][k], acc[ai][bj][m][n], 0, 0, 0); __builtin_amdgcn_s_setprio(0); } while (0)
#define PG8_WAIT_V(n) asm volatile("s_waitcnt vmcnt(" #n ")" ::: "memory")
#define PG8_WAIT_L(n) asm volatile("s_waitcnt lgkmcnt(" #n ")" ::: "memory")
#define PG8_BAR __builtin_amdgcn_s_barrier()
#define PG8_SCHED __builtin_amdgcn_sched_barrier(0)
    Unit cur, nxt; int ui = 0;
    if (!S.next(0, cur)) return;
    f32x4 acc[2][2][4][2];
#pragma unroll
    for (int a = 0; a < 2; ++a)
#pragma unroll
        for (int b = 0; b < 2; ++b)
#pragma unroll
            for (int m = 0; m < 4; ++m)
#pragma unroll
                for (int n = 0; n < 2; ++n) acc[a][b][m][n] = (f32x4){0.f, 0.f, 0.f, 0.f};
    bf16x8 At[4][2], B0[2][2], B1[2][2];
    const char* cA = (const char*)g.A + (size_t)cur.pm * tstep + (size_t)cur.kt0 * kstep; const char* cB = (const char*)g.Bt + (size_t)cur.pn * tstep + (size_t)cur.kt0 * kstep;
    if constexpr (SP2) {
        PG8_STAGE(PG8_SB(0, 0), cB, voffB); PG8_STAGE(PG8_SB(0, 1), cB + hstep, voffB); PG8_STAGE(PG8_SA(0, 0), cA, voffA); PG8_STAGE(PG8_SA(0, 1), cA + hstep, voffA);
        if (wr == 1) PG8_BAR;
        PG8_WAIT_V(2); PG8_BAR;
        PG8_STAGE(PG8_SB(1, 0), cB + kstep, voffB); PG8_STAGE(PG8_SA(1, 0), cA + kstep, voffA); PG8_STAGE(PG8_SB(1, 1), cB + hstep + kstep, voffB);
        PG8_WAIT_V(6); PG8_BAR;
    } else {
        PG8_STAGE(PG8_SB(0, 0), cB, voffB); PG8_STAGE(PG8_SA(0, 0), cA, voffA); PG8_STAGE(PG8_SB(0, 1), cB + hstep, voffB); PG8_STAGE(PG8_SA(0, 1), cA + hstep, voffA);
        if (wr == 1) PG8_BAR;
        PG8_WAIT_V(4); PG8_BAR;
        PG8_STAGE(PG8_SB(1, 0), cB + kstep, voffB); PG8_STAGE(PG8_SA(1, 0), cA + kstep, voffA); PG8_STAGE(PG8_SB(1, 1), cB + hstep + kstep, voffB);
        PG8_WAIT_V(6); PG8_BAR;
    }
    for (;;) {
        const bool has_next = S.next(ui + 1, nxt);
        const char* nA = has_next ? (const char*)g.A + (size_t)nxt.pm * tstep + (size_t)nxt.kt0 * kstep : cA; const char* nB = has_next ? (const char*)g.Bt + (size_t)nxt.pn * tstep + (size_t)nxt.kt0 * kstep : cB;
        const int nt = cur.nt;
        for (int t = 0; t < nt; t += 2) {
            const bool last = (t == nt - 2);
            const char* a1 = cA + (size_t)(t + 1) * kstep;
            const char* a2 = last ? nA : cA + (size_t)(t + 2) * kstep; const char* b2 = last ? nB : cB + (size_t)(t + 2) * kstep;
            const char* a3 = a2 + kstep; const char* b3 = b2 + kstep;
            if constexpr (Epi::KSEG) { if ((t == 6 || t == 10) && nt == 16) { E.kseg(acc, cur, t, wr, fr); if (!E.ftab) PG8_WAIT_V(0); PG8_SCHED; } }
            if constexpr (SP2) {
            PG8_LDB(B0, 0, 0); PG8_LDB(B1, 0, 1); PG8_SCHED; PG8_LDA(At, 0, 0); PG8_STAGE(PG8_SA(1, 1), a1 + hstep, voffA);
            PG8_WAIT_V(8); PG8_WAIT_L(0); PG8_BAR; PG8_MMA(0, 0, At, B0); PG8_MMA(0, 1, At, B1); PG8_BAR; PG8_SCHED;
            PG8_LDA(At, 0, 1); PG8_STAGE(PG8_SB(0, 0), b2, voffB); PG8_STAGE(PG8_SB(0, 1), b2 + hstep, voffB); PG8_STAGE(PG8_SA(0, 0), a2, voffA);
            PG8_WAIT_V(8); PG8_WAIT_L(0); PG8_BAR; PG8_MMA(1, 0, At, B0); PG8_MMA(1, 1, At, B1); PG8_BAR; PG8_SCHED;
            PG8_LDB(B0, 1, 0); PG8_LDB(B1, 1, 1); PG8_SCHED; PG8_LDA(At, 1, 0); PG8_STAGE(PG8_SA(0, 1), a2 + hstep, voffA);
            PG8_WAIT_V(8); PG8_WAIT_L(0); PG8_BAR; PG8_MMA(0, 0, At, B0); PG8_MMA(0, 1, At, B1); PG8_BAR; PG8_SCHED;
            PG8_LDA(At, 1, 1); PG8_STAGE(PG8_SB(1, 0), b3, voffB); PG8_STAGE(PG8_SB(1, 1), b3 + hstep, voffB); PG8_STAGE(PG8_SA(1, 0), a3, voffA);
            PG8_WAIT_V(8); PG8_WAIT_L(0); PG8_BAR; PG8_MMA(1, 0, At, B0); PG8_MMA(1, 1, At, B1); PG8_BAR; PG8_SCHED;
            } else {
            PG8_LDB(B0, 0, 0); PG8_SCHED; PG8_LDA(At, 0, 0); PG8_STAGE(PG8_SA(1, 1), a1 + hstep, voffA);
            PG8_WAIT_L(8); PG8_BAR; PG8_WAIT_L(0); PG8_MMA(0, 0, At, B0); PG8_BAR; PG8_SCHED;
            PG8_LDB(B1, 0, 1); PG8_STAGE(PG8_SB(0, 0), b2, voffB);
            PG8_BAR; PG8_WAIT_L(0); PG8_MMA(0, 1, At, B1); PG8_BAR;
            PG8_LDA(At, 0, 1); PG8_STAGE(PG8_SA(0, 0), a2, voffA);
            PG8_BAR; PG8_WAIT_L(0); PG8_MMA(1, 0, At, B0); PG8_BAR; PG8_SCHED;
            PG8_STAGE(PG8_SB(0, 1), b2 + hstep, voffB);
            PG8_WAIT_V(6); PG8_BAR; PG8_MMA(1, 1, At, B1); PG8_BAR;
            PG8_LDB(B0, 1, 0); PG8_SCHED; PG8_LDA(At, 1, 0); PG8_STAGE(PG8_SA(0, 1), a2 + hstep, voffA);
            PG8_WAIT_L(8); PG8_BAR; PG8_WAIT_L(0); PG8_MMA(0, 0, At, B0); PG8_BAR; PG8_SCHED;
            PG8_LDB(B1, 1, 1); PG8_STAGE(PG8_SB(1, 0), b3, voffB);
            PG8_BAR; PG8_WAIT_L(0); PG8_MMA(0, 1, At, B1); PG8_BAR;
            PG8_LDA(At, 1, 1); PG8_STAGE(PG8_SA(1, 0), a3, voffA);
            PG8_BAR; PG8_WAIT_L(0); PG8_MMA(1, 0, At, B0); PG8_BAR; PG8_SCHED;
            PG8_STAGE(PG8_SB(1, 1), b3 + hstep, voffB);
            PG8_WAIT_V(6); PG8_BAR; PG8_MMA(1, 1, At, B1); PG8_BAR;
            }
        }
        if constexpr (ALIGN_EPI) { if (wr == 0) PG8_BAR; }
        E(acc, cur, wr, wc, fr, fq);
        if (!has_next) break;
#pragma unroll
        for (int a = 0; a < 2; ++a)
#pragma unroll
            for (int b = 0; b < 2; ++b)
#pragma unroll
                for (int m = 0; m < 4; ++m)
#pragma unroll
                    for (int n = 0; n < 2; ++n) acc[a][b][m][n] = (f32x4){0.f, 0.f, 0.f, 0.f};
        cur = nxt; cA = nA; cB = nB; ++ui;
        if constexpr (ALIGN_EPI) { if (wr == 1) PG8_BAR; }
    }
    PG8_WAIT_V(0);
    if constexpr (!ALIGN_EPI) { if (wr == 0) PG8_BAR; }
    PG8_BAR;
#undef PG8_SA
#undef PG8_SB
#undef PG8_STAGE
#undef PG8_LDA
#undef PG8_LDB
#undef PG8_MMA
#undef PG8_WAIT_V
#undef PG8_WAIT_L
#undef PG8_BAR
#undef PG8_SCHED
}
}

namespace at {
constexpr int PITCH = DIN, OPITCH = DM, SLOTB = 8192;
constexpr int L_K = 0, L_V = 2 * SLOTB, L_WS = 4 * SLOTB, L_OST = L_WS + 2048, L_BIAS = L_OST + 8 * 4096, L_END = L_BIAS + 2048;
__device__ __forceinline__ int crow(int r, int hi) { return (r & 3) + 8 * (r >> 2) + 4 * hi; }
__device__ __forceinline__ void glds16(const void* gsrc, unsigned lds_dst) { unsigned keep;
    asm volatile("s_mov_b32 %0, m0\n\ts_mov_b32 m0, %2\n\ts_nop 0\n\tglobal_load_lds_dwordx4 %1, off\n\ts_mov_b32 m0, %0" : "=&s"(keep) : "v"(gsrc), "s"(lds_dst) : "memory"); }
__device__ __forceinline__ unsigned cvtpk_s(float lo, float hi) { typedef __bf16 bf16x2_t __attribute__((ext_vector_type(2))); f32x2 v = {lo, hi}; bf16x2_t b = __builtin_convertvector(v, bf16x2_t); return __builtin_bit_cast(unsigned, b); }
#define AT_WAIT_BAR(N) asm volatile("s_waitcnt vmcnt(" #N ") lgkmcnt(0)\n\ts_barrier" ::: "memory")
#define AT_SBAR() __builtin_amdgcn_sched_barrier(0)

__device__ __forceinline__ void qkt(f32x16& p0, f32x16& p1, const char* Kslot, const bf16x8* qr, int r32, int hi) {
    const char* kb = Kslot + hi * 1024 + r32 * 16;
    const f32x16 z = {};
#pragma unroll
    for (int d0 = 0; d0 < 4; ++d0) {
        const bf16x8 b0 = *reinterpret_cast<const bf16x8*>(kb + d0 * 2048);
        const bf16x8 b1 = *reinterpret_cast<const bf16x8*>(kb + d0 * 2048 + 512);
        if (d0 == 0) { p0 = __builtin_amdgcn_mfma_f32_32x32x16_bf16(b0, qr[0], z, 0, 0, 0); p1 = __builtin_amdgcn_mfma_f32_32x32x16_bf16(b1, qr[0], z, 0, 0, 0); }
        else { p0 = __builtin_amdgcn_mfma_f32_32x32x16_bf16(b0, qr[d0], p0, 0, 0, 0); p1 = __builtin_amdgcn_mfma_f32_32x32x16_bf16(b1, qr[d0], p1, 0, 0, 0); } }
}
__device__ __forceinline__ float rowmax(const f32x16& p0, const f32x16& p1) {
    float a = fmaxf(p0[0], p1[0]);
#pragma unroll
    for (int r = 1; r < 16; ++r) a = fmaxf(a, fmaxf(p0[r], p1[r]));
    return fmaxf(a, __shfl_xor(a, 32));
}
__device__ __forceinline__ void pv(f32x16* o, int vb, bf16x8 pa0, bf16x8 pa1, bf16x8 pa2, bf16x8 pa3) {
#pragma unroll
    for (int d0 = 0; d0 < 2; ++d0) { s16x4 lo[4], hi[4];
#pragma unroll
        for (int ks = 0; ks < 4; ++ks) {
            asm volatile("ds_read_b64_tr_b16 %0,%1 offset:%c2" : "=&v"(lo[ks]) : "v"(vb), "i"(d0 * 4096 + ks * 1024) : "memory");
            asm volatile("ds_read_b64_tr_b16 %0,%1 offset:%c2" : "=&v"(hi[ks]) : "v"(vb), "i"(d0 * 4096 + ks * 1024 + 512) : "memory"); }
        asm volatile("s_waitcnt lgkmcnt(0)" ::: "memory"); AT_SBAR();
#define AT_PK(k) (bf16x8){lo[k][0], lo[k][1], lo[k][2], lo[k][3], hi[k][0], hi[k][1], hi[k][2], hi[k][3]}
        o[d0] = __builtin_amdgcn_mfma_f32_32x32x16_bf16(pa0, AT_PK(0), o[d0], 0, 0, 0);
        o[d0] = __builtin_amdgcn_mfma_f32_32x32x16_bf16(pa1, AT_PK(1), o[d0], 0, 0, 0);
        o[d0] = __builtin_amdgcn_mfma_f32_32x32x16_bf16(pa2, AT_PK(2), o[d0], 0, 0, 0);
        o[d0] = __builtin_amdgcn_mfma_f32_32x32x16_bf16(pa3, AT_PK(3), o[d0], 0, 0, 0);
#undef AT_PK
    }
}
__device__ __forceinline__ void store_tile(const f32x16* o, const float* rli, bf16_t* stg, bf16_t* Ow, int pitch, float* ss, int lane, int r32, int hi) {
#pragma unroll
    for (int r = 0; r < 16; ++r) { const int orow = crow(r, hi);
#pragma unroll
        for (int d0 = 0; d0 < 2; ++d0) stg[orow * 64 + d0 * 32 + r32] = (bf16_t)(cvtpk_s(o[d0][r] * rli[r], 0.f) & 0xffffu); }
    asm volatile("s_waitcnt lgkmcnt(0)" ::: "memory");
#pragma unroll
    for (int i = 0; i < 4; ++i) { const int row = i * 8 + (lane >> 3), ch = lane & 7; const u32x4 v = *(const u32x4*)(stg + row * 64 + ch * 8);
        { const bf16_t* gp_ = Ow + (long)row * pitch + ch * 8; asm volatile("global_store_dwordx4 %0, %1, off sc0 sc1\n\ts_nop 1" :: "v"(gp_), "v"(v) : "memory"); }
        float s = 0.f;
#pragma unroll
        for (int j = 0; j < 4; ++j) { const float a = __uint_as_float(v[j] << 16), b = __uint_as_float(v[j] & 0xffff0000u); s += a * a + b * b; }
        s += __shfl_xor(s, 1); s += __shfl_xor(s, 2); s += __shfl_xor(s, 4);
        if (ch == 0) atomicAdd(ss + (long)row * 4, s); }
    asm volatile("s_waitcnt lgkmcnt(0)" ::: "memory");
}

struct Job { const bf16_t* Q; const bf16_t* Kc; const bf16_t* Vc; const bf16_t* Kl; const bf16_t* Vl; bf16_t* O; float* ss; int nctx, lt0, nlt, r0; };
template <int MODE> __device__ __forceinline__ void unit(const Job& J, char* shm) {
    const int tid = opaque_tid(), lane = tid & 63, r32 = lane & 31, hi = lane >> 5; const int wid = __builtin_amdgcn_readfirstlane(tid >> 6);
    const unsigned lds0 = (unsigned)(uintptr_t)shm;
    float* wsf = (float*)(shm + L_WS) + wid * 64;
    const long koff = (long)lane * PITCH + wid * 8;
    const long voff = (long)(16 * (wid & 3) + (lane >> 2)) * PITCH + (wid >> 2) * 32 + (lane & 3) * 8;
    const unsigned kdst = lds0 + L_K + wid * 1024, vdst = lds0 + L_V + wid * 1024;
    const int nt = J.nctx + J.nlt;
#define AT_DMA(t, slot) do { const int t_ = (t); const bf16_t* kp_ = (t_ < J.nctx) ? J.Kc + (long)t_ * 64 * PITCH : J.Kl + (long)(J.lt0 + t_ - J.nctx) * 64 * PITCH; \
        const bf16_t* vp_ = (t_ < J.nctx) ? J.Vc + (long)t_ * 64 * PITCH : J.Vl + (long)(J.lt0 + t_ - J.nctx) * 64 * PITCH; \
        glds16(kp_ + koff, (unsigned)__builtin_amdgcn_readfirstlane(kdst + (slot))); glds16(vp_ + voff, (unsigned)__builtin_amdgcn_readfirstlane(vdst + (slot))); } while (0)
    AT_DMA(0, 0);
    bf16x8 qr[4];
    const bf16_t* Qw = J.Q + (long)(wid * 32 + r32) * PITCH;
#pragma unroll
    for (int d0 = 0; d0 < 4; ++d0) qr[d0] = *reinterpret_cast<const bf16x8*>(Qw + d0 * 16 + hi * 8);
    float m_run = -INFINITY, l_reg = 0.f; f32x16 o[2]; o[0] = f32x16{}; o[1] = f32x16{};
    int gr = 0, rs = 0, qc = 0, cs = 0;
    if (MODE == 1) { gr = J.r0 + (wid >> 1); rs = min(max(gr - 4, 0), 120); qc = 32 * (wid & 1) + r32; cs = min(max(qc - 8, 0), 48); }
    const int vb0 = (int)(lds0 + L_V) + ((lane >> 4) & 1) * 32 + (lane & 3) * 8 + (4 * hi + ((lane & 15) >> 2)) * 64;
    for (int t = 0; t < nt; ++t) {
        const int sl = (t & 1) * SLOTB;
        if (t + 1 < nt) { AT_DMA(t + 1, ((t + 1) & 1) * SLOTB); AT_WAIT_BAR(2); } else { AT_WAIT_BAR(0); }
        bool active = true; int dr = 0;
        if (MODE == 1 && t >= J.nctx) { const int kr = J.lt0 + t - J.nctx; active = (unsigned)(kr - rs) < 8u; dr = kr - gr + 7; }
        if (active) {
            f32x16 p0, p1; qkt(p0, p1, shm + L_K + sl, qr, r32, hi);
            if (MODE == 1 && t >= J.nctx) {
                const float* bl = (const float*)(shm + L_BIAS) + dr * 31 + 15 - qc;
#pragma unroll
                for (int r = 0; r < 16; ++r) { const int kc = crow(r, hi);
                    const bool v0 = (unsigned)(kc - cs) < 16u, v1 = (unsigned)(kc + 32 - cs) < 16u;
                    const float b0 = bl[v0 ? kc : qc], b1 = bl[v1 ? kc + 32 : qc];
                    p0[r] = v0 ? p0[r] + b0 : -INFINITY; p1[r] = v1 ? p1[r] + b1 : -INFINITY; }
            }
            const float rm = rowmax(p0, p1);
            const float mnew = fmaxf(m_run, rm);
            if (__any(mnew > m_run)) {
                const float f = __builtin_amdgcn_exp2f(m_run - mnew); l_reg *= f; m_run = mnew;
                if (hi == 0) wsf[r32] = f;
                asm volatile("s_waitcnt lgkmcnt(0)" ::: "memory");
#pragma unroll
                for (int r = 0; r < 16; ++r) { const float fr_ = wsf[crow(r, hi)]; o[0][r] *= fr_; o[1][r] *= fr_; }
            }
            float sacc = 0.f;
#pragma unroll
            for (int r = 0; r < 16; ++r) { p0[r] = __builtin_amdgcn_exp2f(p0[r] - m_run); p1[r] = __builtin_amdgcn_exp2f(p1[r] - m_run); sacc += p0[r] + p1[r]; }
            l_reg += sacc;
            u32x4 pw0, pw1, pw2, pw3;
            pw0 = (u32x4){cvtpk_s(p0[0], p0[1]), cvtpk_s(p0[2], p0[3]), cvtpk_s(p0[4], p0[5]), cvtpk_s(p0[6], p0[7])};
            pw1 = (u32x4){cvtpk_s(p0[8], p0[9]), cvtpk_s(p0[10], p0[11]), cvtpk_s(p0[12], p0[13]), cvtpk_s(p0[14], p0[15])};
            pw2 = (u32x4){cvtpk_s(p1[0], p1[1]), cvtpk_s(p1[2], p1[3]), cvtpk_s(p1[4], p1[5]), cvtpk_s(p1[6], p1[7])};
            pw3 = (u32x4){cvtpk_s(p1[8], p1[9]), cvtpk_s(p1[10], p1[11]), cvtpk_s(p1[12], p1[13]), cvtpk_s(p1[14], p1[15])};
            AT_SBAR();
            pv(o, vb0 + sl, __builtin_bit_cast(bf16x8, pw0), __builtin_bit_cast(bf16x8, pw1), __builtin_bit_cast(bf16x8, pw2), __builtin_bit_cast(bf16x8, pw3));
        }
        asm volatile("s_waitcnt lgkmcnt(0)\n\ts_barrier" ::: "memory");
    }
#undef AT_DMA
    l_reg += __shfl_xor(l_reg, 32);
    if (hi == 0) wsf[32 + r32] = l_reg;
    asm volatile("s_waitcnt lgkmcnt(0)" ::: "memory");
    float rli[16];
#pragma unroll
    for (int r = 0; r < 16; ++r) rli[r] = __builtin_amdgcn_rcpf(wsf[32 + crow(r, hi)]);
    store_tile(o, rli, (bf16_t*)(shm + L_OST) + wid * 2048, J.O + (long)(wid * 32) * OPITCH, OPITCH, J.ss + (long)(wid * 32) * 4, lane, r32, hi);
    asm volatile("s_waitcnt vmcnt(0) lgkmcnt(0)\n\ts_barrier" ::: "memory");
}
}


namespace ap {
using at::crow; using at::glds16; using at::cvtpk_s;
constexpr int PITCH = DIN, OPITCH = DM, KVBLK = 64, QBLK = 32, NW = 8;
#define SBAR() __builtin_amdgcn_sched_barrier(0)
constexpr int NSLOT = 3, SLOTB = 8192;
constexpr int LDS_K = 0, LDS_V = NSLOT * SLOTB, LDS_WS = 2 * NSLOT * SLOTB, LDS_OST = LDS_WS + NW * 64 * 4, LDS_BYTES_ = LDS_OST + NW * 4096;
__device__ __forceinline__ float max3f(float a, float b, float c) { float r; asm("v_max3_f32 %0, %1, %2, %3" : "=v"(r) : "v"(a), "v"(b), "v"(c)); return r; }
__device__ __forceinline__ float max2f(float a, float b) { float r; asm("v_max_f32_e32 %0, %1, %2" : "=v"(r) : "v"(a), "v"(b)); return r; }
__device__ __forceinline__ float fadd_s(float a, float b) { float r; asm("v_add_f32_e32 %0, %1, %2" : "=v"(r) : "v"(a), "v"(b)); return r; }
__device__ __forceinline__ float fsub_s(float a, float b) { float r; asm("v_sub_f32_e32 %0, %1, %2" : "=v"(r) : "v"(a), "v"(b)); return r; }
#define WAIT_BAR(N) asm volatile("s_waitcnt vmcnt(" #N ") lgkmcnt(0)\n\ts_barrier" ::: "memory")
__device__ __forceinline__ void qkt(f32x16& p0, f32x16& p1, const char* Kslot, const bf16x8* qr, const f32x16& negm, int r32, int hi) {
    const char* kb = Kslot + hi * 1024 + r32 * 16;
#pragma unroll
    for (int d0 = 0; d0 < 4; ++d0) {
        const bf16x8 b0 = *reinterpret_cast<const bf16x8*>(kb + d0 * 2048);
        const bf16x8 b1 = *reinterpret_cast<const bf16x8*>(kb + d0 * 2048 + 512);
        if (d0 == 0) { p0 = __builtin_amdgcn_mfma_f32_32x32x16_bf16(b0, qr[0], negm, 0, 0, 0); p1 = __builtin_amdgcn_mfma_f32_32x32x16_bf16(b1, qr[0], negm, 0, 0, 0); }
        else { p0 = __builtin_amdgcn_mfma_f32_32x32x16_bf16(b0, qr[d0], p0, 0, 0, 0); p1 = __builtin_amdgcn_mfma_f32_32x32x16_bf16(b1, qr[d0], p1, 0, 0, 0); } }
}
typedef __attribute__((address_space(3))) const char* lds_cptr;
typedef short v4i16_t __attribute__((ext_vector_type(4)));
__device__ __forceinline__ void kload8(bf16x8* kf, lds_cptr kp) {
    kf[0] = *(const LAS bf16x8*)(kp);        kf[1] = *(const LAS bf16x8*)(kp + 512);
    kf[2] = *(const LAS bf16x8*)(kp + 2048); kf[3] = *(const LAS bf16x8*)(kp + 2560);
    kf[4] = *(const LAS bf16x8*)(kp + 4096); kf[5] = *(const LAS bf16x8*)(kp + 4608);
    kf[6] = *(const LAS bf16x8*)(kp + 6144); kf[7] = *(const LAS bf16x8*)(kp + 6656);
}
__device__ __forceinline__ void kload2(bf16x8* kf, lds_cptr kp, int j) { kf[2 * j] = *(const LAS bf16x8*)(kp + j * 2048); kf[2 * j + 1] = *(const LAS bf16x8*)(kp + j * 2048 + 512); }
__device__ __forceinline__ s16x4 vtr(lds_cptr p) { return __builtin_bit_cast(s16x4, __builtin_amdgcn_ds_read_tr16_b64_v4i16((LAS v4i16_t*)p)); }
__device__ __forceinline__ float rowmax(const f32x16& p0, const f32x16& p1) {
    float a = max3f(p0[0], p0[1], p1[0]), b = max3f(p0[2], p0[3], p1[1]); a = max3f(a, p1[2], p1[3]);
#pragma unroll
    for (int r = 4; r < 16; r += 4) { a = max3f(a, p0[r], p0[r + 1]); b = max3f(b, p0[r + 2], p0[r + 3]); a = max3f(a, p1[r], p1[r + 1]); b = max3f(b, p1[r + 2], p1[r + 3]); }
    const float m = max2f(a, b);
    auto rr = __builtin_amdgcn_permlane32_swap(__float_as_uint(m), __float_as_uint(m), false, false);
    return max2f(__uint_as_float(rr[0]), __uint_as_float(rr[1]));
}
__device__ __forceinline__ void glds16s(unsigned voff, const void* sbase, unsigned lds_dst) { unsigned keep;
    asm volatile("s_mov_b32 %0, m0\n\ts_mov_b32 m0, %3\n\ts_nop 0\n\tglobal_load_lds_dwordx4 %1, %2\n\ts_mov_b32 m0, %0" : "=&s"(keep) : "v"(voff), "s"(sbase), "s"(lds_dst) : "memory"); }
constexpr int LDS_NABIAS = 86016;
template <int THRL, int MODE> __device__ __forceinline__ void unit(const bf16_t* Q, const bf16_t* __restrict__ Kh, const bf16_t* __restrict__ Vh, bf16_t* O, float* ss, const int NT, char* shm, const int lt0, const int r0, const float bref = 0.f) {
    const int tid = opaque_tid(), lane = tid & 63, r32 = lane & 31, hi = lane >> 5; const int wid = __builtin_amdgcn_readfirstlane(tid >> 6);
    const bf16_t* Qw = Q + (long)(wid * QBLK) * PITCH;
    const unsigned lds0 = (unsigned)(uintptr_t)shm;
    float* wsf = (float*)(shm + LDS_WS) + wid * 64;
    const unsigned kvo = (unsigned)((lane * PITCH + wid * 8) * 2);
    const unsigned vvo = (unsigned)(((16 * (wid & 3) + (lane >> 2)) * PITCH + (wid >> 2) * 32 + (lane & 3) * 8) * 2);
    const unsigned kdst = lds0 + LDS_K + wid * 1024, vdst = lds0 + LDS_V + wid * 1024;
#define TROW(t) (MODE == 1 ? ((t) < 4 ? SEQ + 64 * (t) : 64 * (lt0 + (t) - 4)) : 64 * (t))
#define DMA_K(t, slot) glds16s(kvo, Kh + (long)TROW(t) * PITCH, (unsigned)__builtin_amdgcn_readfirstlane(kdst + (slot)))
#define DMA_V(t, slot) glds16s(vvo, Vh + (long)TROW(t) * PITCH, (unsigned)__builtin_amdgcn_readfirstlane(vdst + (slot)))
    const char* Kbase = shm + LDS_K; bf16x8 kf[8];
    const lds_cptr shm3 = (lds_cptr)shm; const lds_cptr kp0 = shm3 + LDS_K + hi * 1024 + r32 * 16; const lds_cptr vp0 = shm3 + LDS_V + ((lane >> 4) & 1) * 32 + (lane & 3) * 8 + (4 * hi + ((lane & 15) >> 2)) * 64;
    DMA_K(0, 0); DMA_V(0, 0); DMA_K(1, SLOTB);
    bf16x8 qr[4];
#pragma unroll
    for (int d0 = 0; d0 < 4; ++d0) qr[d0] = *reinterpret_cast<const bf16x8*>(&Qw[(long)r32 * PITCH + d0 * 16 + hi * 8]);
    float mhat = (MODE == 0) ? bref : 0.f, l_reg = 0.f; f32x16 o[2]; o[0] = f32x16{}; o[1] = f32x16{}; f32x16 negm = f32x16{};
    if (MODE == 0) { _Pragma("unroll") for (int r = 0; r < 16; ++r) negm[r] = -bref; }
    if (MODE != 1) asm volatile("" : "+v"(negm));
    int na_gr = 0, na_rs = 0, na_qc = 0, na_cs = 0;
    if (MODE == 1) { na_gr = r0 + (wid >> 1); na_rs = min(max(na_gr - 4, 0), 120); na_qc = 32 * (wid & 1) + r32; na_cs = min(max(na_qc - 8, 0), 48); }
#define CMASK(P0, P1, t) do { if (MODE == 1) { if ((t) >= 4) { const int kr_ = lt0 + (t) - 4; \
        if ((unsigned)(kr_ - na_rs) < 8u) { const float* bl_ = (const float*)(shm + LDS_NABIAS) + (kr_ - na_gr + 7) * 31 + 15 - na_qc; \
            _Pragma("unroll") for (int r4 = 0; r4 < 16; r4 += 4) { \
                _Pragma("unroll") for (int r = r4; r < r4 + 4; ++r) { const int kc_ = crow(r, hi); const bool v0_ = (unsigned)(kc_ - na_cs) < 16u, v1_ = (unsigned)(kc_ + 32 - na_cs) < 16u; \
                    const float b0_ = bl_[kc_], b1_ = bl_[kc_ + 32];        P0[r] = v0_ ? P0[r] + (b0_ - mhat) : -INFINITY; P1[r] = v1_ ? P1[r] + (b1_ - mhat) : -INFINITY; } \
                SBAR(); } } \
        else { _Pragma("unroll") for (int r = 0; r < 16; ++r) { P0[r] = -INFINITY; P1[r] = -INFINITY; } } } \
      else { _Pragma("unroll") for (int r = 0; r < 16; ++r) { P0[r] -= mhat; P1[r] -= mhat; } } } } while (0)
#define NEGMC (MODE == 1 ? (f32x16){0.f, 0.f, 0.f, 0.f, 0.f, 0.f, 0.f, 0.f, 0.f, 0.f, 0.f, 0.f, 0.f, 0.f, 0.f, 0.f} : negm)
    bool resc = false;
#define START(P0, P1) do { resc = false; \
    if (MODE == 1) { const float rm = rowmax(P0, P1); const float dl = rm; mhat = fadd_s(mhat, dl); \
      _Pragma("unroll") for (int r = 0; r < 16; ++r) { P0[r] = fsub_s(P0[r], dl); P1[r] = fsub_s(P1[r], dl); } \
      if (MODE != 1) { _Pragma("unroll") for (int r = 0; r < 16; ++r) negm[r] = -mhat; asm volatile("" : "+v"(negm)); } } \
    _Pragma("unroll") for (int r = 0; r < 16; ++r) P0[r] = __builtin_amdgcn_exp2f(P0[r]); } while (0)
#define RESC() do { if (resc) { asm volatile("s_waitcnt lgkmcnt(0)" ::: "memory"); \
      _Pragma("unroll") for (int d_ = 0; d_ < 2; ++d_) _Pragma("unroll") for (int r = 0; r < 16; ++r) o[d_][r] *= wsf[crow(r, hi)]; } } while (0)
    f32x16 pA0, pA1, pB0, pB1;
    int sl_prev = 0, sl_cur = 0, sl_next = SLOTB;
#define ROT() do { sl_prev = sl_cur; sl_cur = sl_next; sl_next = (sl_next == (NSLOT - 1) * SLOTB) ? 0 : sl_next + SLOTB; } while (0)
    DMA_K(2, 2 * SLOTB);
    WAIT_BAR(3);
    qkt(pA0, pA1, Kbase, qr, negm, r32, hi); asm volatile("s_nop 15\n\ts_nop 7" : "+v"(pA0), "+v"(pA1));
    START(pA0, pA1);
    _Pragma("unroll") for (int r = 0; r < 16; ++r) pA1[r] = __builtin_amdgcn_exp2f(pA1[r]);
    WAIT_BAR(0);
    DMA_K(3, 0); DMA_V(1, SLOTB);
    ROT();
    kload8(kf, kp0 + sl_cur);
    WAIT_BAR(2);
    s16x4 vlo[8], vhi[8]; u32x4 pw0, pw1, pw2, pw3;
#define PKW(P, B) cvtpk_s(P[B], P[B + 1])
#define PAF(k) __builtin_bit_cast(bf16x8, pw##k)
#define VFR(i) (bf16x8){vlo[i][0], vlo[i][1], vlo[i][2], vlo[i][3], vhi[i][0], vhi[i][1], vhi[i][2], vhi[i][3]}
#define PIN(x) asm volatile("" : "+v"(x))
#define MX3(a, b, c) __builtin_fmaxf(__builtin_fmaxf((a), (b)), (c))
#define GAPA(MF, A0, A1, A2, A3, W0, W1, PW) do { MF; sacc += A0; sacc += A1; sacc += A2; sacc += A3; PIN(sacc); W0; W1; PIN(PW); SBAR(); } while (0)
#define EX(v) __builtin_amdgcn_exp2f(v)
#define GAPB(MF, X, B) do { MF; X[B] = EX(X[B]); X[B + 1] = EX(X[B + 1]); X[B + 2] = EX(X[B + 2]); X[B + 3] = EX(X[B + 3]); PIN(X); SBAR(); } while (0)
#define VRD(i) do { vlo[i] = vtr(vp_ + (((i) >> 2) * 4096 + ((i) & 3) * 1024)); vhi[i] = vtr(vp_ + (((i) >> 2) * 4096 + ((i) & 3) * 1024 + 512)); } while (0)
#define KRD(G, j) do { if (G) { kload2(kf, kp0 + sl_next, j); SBAR(); } } while (0)
#define STEP(C0, C1, P0, P1, t, GK, GV, GL) do { SBAR(); \
    const lds_cptr vp_ = vp0 + sl_prev; \
    VRD(0); SBAR(); float sacc = (P0[0] + P0[1]); \
    GAPA(C0 = __builtin_amdgcn_mfma_f32_32x32x16_bf16(kf[0], qr[0], NEGMC, 0, 0, 0), P0[2], P0[3], P0[4], P0[5],     pw0[0] = PKW(P0, 0), pw0[1] = PKW(P0, 2), pw0); \
    VRD(4); SBAR(); GAPA(C1 = __builtin_amdgcn_mfma_f32_32x32x16_bf16(kf[1], qr[0], NEGMC, 0, 0, 0), P0[6], P0[7], P0[8], P0[9],     pw0[2] = PKW(P0, 4), pw0[3] = PKW(P0, 6), pw0); \
    VRD(1); SBAR(); GAPA(C0 = __builtin_amdgcn_mfma_f32_32x32x16_bf16(kf[2], qr[1], C0, 0, 0, 0),   P0[10], P0[11], P0[12], P0[13], pw1[0] = PKW(P0, 8), pw1[1] = PKW(P0, 10), pw1); \
    VRD(5); SBAR(); GAPA(C1 = __builtin_amdgcn_mfma_f32_32x32x16_bf16(kf[3], qr[1], C1, 0, 0, 0),   P0[14], P0[15], P1[0], P1[1],   pw1[2] = PKW(P0, 12), pw1[3] = PKW(P0, 14), pw1); \
    VRD(2); SBAR(); GAPA(C0 = __builtin_amdgcn_mfma_f32_32x32x16_bf16(kf[4], qr[2], C0, 0, 0, 0),   P1[2], P1[3], P1[4], P1[5],     pw2[0] = PKW(P1, 0), pw2[1] = PKW(P1, 2), pw2); \
    VRD(6); SBAR(); GAPA(C1 = __builtin_amdgcn_mfma_f32_32x32x16_bf16(kf[5], qr[2], C1, 0, 0, 0),   P1[6], P1[7], P1[8], P1[9],     pw2[2] = PKW(P1, 4), pw2[3] = PKW(P1, 6), pw2); \
    VRD(3); SBAR(); GAPA(C0 = __builtin_amdgcn_mfma_f32_32x32x16_bf16(kf[6], qr[3], C0, 0, 0, 0),   P1[10], P1[11], P1[12], P1[13], pw3[0] = PKW(P1, 8), pw3[1] = PKW(P1, 10), pw3); \
    VRD(7); SBAR(); GAPA(C1 = __builtin_amdgcn_mfma_f32_32x32x16_bf16(kf[7], qr[3], C1, 0, 0, 0),   P1[14], P1[15], 0.f, 0.f,       pw3[2] = PKW(P1, 12), pw3[3] = PKW(P1, 14), pw3); \
    l_reg += sacc; \
    if (GK) { DMA_K((t) + 3, sl_cur); } if (GV) { DMA_V((t) + 1, sl_next); } \
    CMASK(C0, C1, t); \
    if (MODE == 1) { float a = MX3(C0[0], C0[1], C1[0]), b = MX3(C0[2], C0[3], C1[1]); a = MX3(a, C1[2], C1[3]); \
      _Pragma("unroll") for (int r = 4; r < 16; r += 4) { a = MX3(a, C0[r], C0[r + 1]); b = MX3(b, C0[r + 2], C0[r + 3]); a = MX3(a, C1[r], C1[r + 1]); b = MX3(b, C1[r + 2], C1[r + 3]); } \
      float rm = __builtin_fmaxf(a, b); { auto rr = __builtin_amdgcn_permlane32_swap(__float_as_uint(rm), __float_as_uint(rm), false, false); rm = __builtin_fmaxf(__uint_as_float(rr[0]), __uint_as_float(rr[1])); } \
      resc = false; \
      if (__builtin_expect(__any(rm > (float)THRL), 0)) { const float dl = __builtin_fmaxf(rm, 0.f); mhat += dl; \
        _Pragma("unroll") for (int r = 0; r < 16; ++r) { C0[r] -= dl; C1[r] -= dl; } \
        if (MODE != 1) { _Pragma("unroll") for (int r = 0; r < 16; ++r) negm[r] = -mhat; asm volatile("" : "+v"(negm)); } \
        const float f = __builtin_amdgcn_exp2f(-dl); l_reg *= f; if (hi == 0) wsf[r32] = f; resc = true; } } \
    SBAR(); \
    GAPB(o[0] = __builtin_amdgcn_mfma_f32_32x32x16_bf16(PAF(0), VFR(0), o[0], 0, 0, 0), C0, 0); \
    GAPB(o[1] = __builtin_amdgcn_mfma_f32_32x32x16_bf16(PAF(0), VFR(4), o[1], 0, 0, 0), C0, 4); \
    KRD(GL, 0); GAPB(o[0] = __builtin_amdgcn_mfma_f32_32x32x16_bf16(PAF(1), VFR(1), o[0], 0, 0, 0), C0, 8); \
    KRD(GL, 1); GAPB(o[1] = __builtin_amdgcn_mfma_f32_32x32x16_bf16(PAF(1), VFR(5), o[1], 0, 0, 0), C0, 12); \
    KRD(GL, 2); GAPB(o[0] = __builtin_amdgcn_mfma_f32_32x32x16_bf16(PAF(2), VFR(2), o[0], 0, 0, 0), C1, 0); \
    KRD(GL, 3); GAPB(o[1] = __builtin_amdgcn_mfma_f32_32x32x16_bf16(PAF(2), VFR(6), o[1], 0, 0, 0), C1, 4); \
    GAPB(o[0] = __builtin_amdgcn_mfma_f32_32x32x16_bf16(PAF(3), VFR(3), o[0], 0, 0, 0), C1, 8); \
    GAPB(o[1] = __builtin_amdgcn_mfma_f32_32x32x16_bf16(PAF(3), VFR(7), o[1], 0, 0, 0), C1, 12); \
    } while (0)
    int t = 1;
    for (; t + 5 < NT; t += 2) {
        STEP(pB0, pB1, pA0, pA1, t, true, true, true);     WAIT_BAR(2); RESC(); ROT();
        STEP(pA0, pA1, pB0, pB1, t + 1, true, true, true); WAIT_BAR(2); RESC(); ROT();
    }
#define ENDW(tt) do { if ((tt) + 3 < NT) { WAIT_BAR(2); } else if ((tt) + 2 < NT) { WAIT_BAR(1); } else { WAIT_BAR(0); } } while (0)
    for (; t + 1 < NT; t += 2) {
        STEP(pB0, pB1, pA0, pA1, t, (t + 3 < NT), (t + 1 < NT), (t + 1 < NT));         ENDW(t);     RESC(); ROT();
        STEP(pA0, pA1, pB0, pB1, t + 1, (t + 4 < NT), (t + 2 < NT), (t + 2 < NT));     ENDW(t + 1); RESC(); ROT();
    }
    STEP(pB0, pB1, pA0, pA1, NT - 1, false, false, false); RESC();
    { float sacc = pB0[0] + pB0[1]; _Pragma("unroll") for (int r = 2; r < 16; ++r) sacc += pB0[r]; _Pragma("unroll") for (int r = 0; r < 16; ++r) sacc += pB1[r]; l_reg += sacc;
      pw0 = (u32x4){PKW(pB0, 0), PKW(pB0, 2), PKW(pB0, 4), PKW(pB0, 6)}; pw1 = (u32x4){PKW(pB0, 8), PKW(pB0, 10), PKW(pB0, 12), PKW(pB0, 14)}; pw2 = (u32x4){PKW(pB1, 0), PKW(pB1, 2), PKW(pB1, 4), PKW(pB1, 6)}; pw3 = (u32x4){PKW(pB1, 8), PKW(pB1, 10), PKW(pB1, 12), PKW(pB1, 14)};
      SBAR(); const int vb0 = (int)(lds0 + LDS_V) + ((lane >> 4) & 1) * 32 + (lane & 3) * 8 + (4 * hi + ((lane & 15) >> 2)) * 64;
      at::pv(o, vb0 + sl_cur, PAF(0), PAF(1), PAF(2), PAF(3)); }
#undef PKW
#undef PAF
#undef VFR
#undef PIN
#undef MX3
#undef GAPA
#undef GAPB
#undef EX
#undef VRD
#undef KRD
#undef STEP
#undef ENDW
    { auto rr = __builtin_amdgcn_permlane32_swap(__float_as_uint(l_reg), __float_as_uint(l_reg), false, false); l_reg = __uint_as_float(rr[0]) + __uint_as_float(rr[1]); }
    if (hi == 0) wsf[32 + r32] = l_reg; asm volatile("s_waitcnt lgkmcnt(0)" ::: "memory");
    float rli[16];
#pragma unroll
    for (int r = 0; r < 16; ++r) rli[r] = __builtin_amdgcn_rcpf(wsf[32 + crow(r, hi)]);
    at::store_tile(o, rli, (bf16_t*)(shm + LDS_OST) + wid * 2048, O + (long)(wid * QBLK) * OPITCH, OPITCH, ss + (long)(wid * QBLK) * 4, lane, r32, hi);
    asm volatile("s_waitcnt vmcnt(0) lgkmcnt(0)\n\ts_barrier" ::: "memory");
#undef DMA_K
#undef DMA_V
#undef TROW
#undef CMASK
#undef NEGMC
#undef START
#undef RESC
#undef ROT
}
#undef SBAR
#undef WAIT_BAR
}

constexpr size_t MiB = 1u << 20;
constexpr size_t WS_CTL = 0;
constexpr size_t CTL_BYTES = 131072;
constexpr size_t WS_MOD = 1 * MiB;
constexpr size_t WS_ROPE = WS_MOD + 512 * 1024;
constexpr size_t WS_SS = 2 * MiB;
constexpr size_t WS_WS = 3 * MiB;
constexpr size_t WS_WIN = 4 * MiB;
constexpr size_t WS_WO = WS_WIN + 4 * (size_t)DIN * DM * 2;
constexpr size_t WS_WF1 = WS_WO + 4 * (size_t)DM * DM * 2;
constexpr size_t WS_WF2 = WS_WF1 + 4 * (size_t)2 * DFF * DM * 2;
constexpr size_t WS_XRES = WS_WF2 + 4 * (size_t)DM * DFF * 2;
constexpr size_t WS_H = WS_XRES + (size_t)MROWS * DM * 4;
constexpr size_t WS_Y = WS_H + (size_t)MROWS * DM * 2;
constexpr size_t WS_QKV = WS_Y + (size_t)MROWS * DM * 2;
constexpr size_t WS_OMIX = WS_QKV + (size_t)MROWS * DIN * 2;
constexpr size_t WS_HID = WS_QKV;
constexpr size_t WS_END = WS_OMIX + (size_t)MROWS * DM * 2;
static_assert((size_t)MROWS * DFF * 2 <= (size_t)MROWS * (DIN + DM) * 2, "hid overlay");
constexpr size_t WS_Y32 = WS_END + MiB;
constexpr size_t WS_TOTAL = WS_Y32 + 11 * 2 * MiB;

constexpr int NWAVES = 8, NTHREADS = 512;
constexpr int RING_BYTES = 131072, LDS_BYTES = 147456;

struct Params {
    const float *x, *c, *ctx, *c_ctx, *w_mod, *b_mod, *w_in, *rpb, *w_s, *b_s, *g_sgu, *g_q, *g_k, *g_out, *w_o, *ln1_g, *ln1_b, *w_ffn_in, *w_ffn_out, *ln2_g, *ln2_b;
    float* out; unsigned char* ws;
};


#define XB_TMO      128
#define XB_XCNT(j)  (256  + 64 * (j))
#define XB_XSUB(j)  (1280 + 64 * (j))
#define XB_XGEN(j)  (2304 + 64 * (j))
#define XB_TOP      3328
#define XB_TOPGEN   3392
#define XCD_BAR_WORDS 3456
#define XB_SPIN_CAP (1u << 22)
__device__ __forceinline__ unsigned xb_ld(unsigned* p)              { return __hip_atomic_load(p, __ATOMIC_RELAXED, __HIP_MEMORY_SCOPE_AGENT); }
__device__ __forceinline__ unsigned xb_add(unsigned* p, unsigned v) { return __hip_atomic_fetch_add(p, v, __ATOMIC_RELAXED, __HIP_MEMORY_SCOPE_AGENT); }
__device__ __forceinline__ unsigned xb_xcc_id() { return (unsigned)__builtin_amdgcn_s_getreg((3 << 11) | 20) & 0xFu; }
#define XB_SPIN(cond, bar) do { unsigned _sp = 0; while (cond) { __builtin_amdgcn_s_sleep(1); \
    if ((++_sp & 255u) == 0u) { if (xb_ld(&(bar)[XB_TMO])) break; if (_sp > XB_SPIN_CAP) { atomicAdd(&(bar)[XB_TMO], 1u); break; } } } } while (0)
struct XcdBarrier { unsigned* bar; unsigned x; volatile LAS unsigned* st; };
__device__ __forceinline__ XcdBarrier xcd_barrier_post(unsigned* bar, volatile LAS unsigned* st) {
    XcdBarrier b; b.bar = bar; b.x = xb_xcc_id(); b.st = st;
    if (threadIdx.x == 0) (void)xb_add(&bar[XB_XCNT(b.x)], 1u);
    return b;
}
__device__ __forceinline__ void xcd_barrier_complete(unsigned* bar, unsigned x, unsigned& nloc, unsigned& nx) {
    const unsigned G = gridDim.x * gridDim.y * gridDim.z;
    unsigned sum, cnt, mine, sp = 0u;
    for (;;) {
        sum = 0u; cnt = 0u; mine = 0u;
#pragma unroll
        for (unsigned j = 0; j < 16; ++j) { const unsigned c = xb_ld(&bar[XB_XCNT(j)]); sum += c; cnt += (c > 0u) ? 1u : 0u; mine = (j == x) ? c : mine; }
        if (sum == G) break;
        __builtin_amdgcn_s_sleep(1);
        if ((++sp & 255u) == 0u) { if (xb_ld(&bar[XB_TMO])) break; if (sp > XB_SPIN_CAP) { atomicAdd(&bar[XB_TMO], 1u); break; } }
    }
    nloc = mine > 0u ? mine : 1u; nx = cnt > 0u ? cnt : 1u;
}
__device__ __forceinline__ void xcd_barrier(const XcdBarrier& b) {
    asm volatile("s_waitcnt vmcnt(0)" ::: "memory");
    __syncthreads();
    if (threadIdx.x == 0) {
        unsigned* bar = b.bar;
        __builtin_amdgcn_s_waitcnt(0);
        unsigned nloc = b.st[0], nx = b.st[1];
        if (nloc == 0u) { xcd_barrier_complete(bar, b.x, nloc, nx); b.st[0] = nloc; b.st[1] = nx; }
        const unsigned old = xb_add(&bar[XB_XSUB(b.x)], 1u);
        const unsigned gen = old / nloc;
        if (old + 1u == (gen + 1u) * nloc) {
            __builtin_amdgcn_fence(__ATOMIC_RELEASE, "agent");
            asm volatile("s_waitcnt vmcnt(0)" ::: "memory");
            const unsigned og = xb_add(&bar[XB_TOP], 1u);
            const unsigned tg = og / nx;
            if (og + 1u == (tg + 1u) * nx) xb_add(&bar[XB_TOPGEN], 1u);
            else XB_SPIN(xb_ld(&bar[XB_TOPGEN]) == tg, bar);
            __builtin_amdgcn_fence(__ATOMIC_ACQUIRE, "agent");
            xb_add(&bar[XB_XGEN(b.x)], 1u);
            asm volatile("s_waitcnt vmcnt(0)" ::: "memory");
        } else {
            XB_SPIN(xb_ld(&bar[XB_XGEN(b.x)]) == gen, bar);
            __builtin_amdgcn_fence(__ATOMIC_ACQUIRE, "agent");
            asm volatile("s_waitcnt vmcnt(0)" ::: "memory");
        }
    }
    __syncthreads();
}

__device__ __forceinline__ void publish_cnt(unsigned* c) {
    asm volatile("s_waitcnt vmcnt(0)" ::: "memory");
    __syncthreads();
    if (threadIdx.x == 0) (void)xb_add(c, 1u);
}
__device__ __forceinline__ void wait_cnt(unsigned* c, unsigned target) {
    if (threadIdx.x == 0) {
        unsigned sp = 0u; while (xb_ld(c) < target) { __builtin_amdgcn_s_sleep(4); if (++sp > (1u << 24)) break; }
        __builtin_amdgcn_fence(__ATOMIC_ACQUIRE, "agent"); asm volatile("s_waitcnt vmcnt(0)" ::: "memory");
    }
    __syncthreads();
}
struct OneUnit { pg8::Unit u; __device__ __forceinline__ bool next(int i, pg8::Unit& o) const { if (i) return false; o = u; return true; } };
constexpr int CW_DEP = 8192;

#ifndef PH
#define PH 0xff
#endif
#ifndef REP_GEMM
#define REP_GEMM 1
#endif
#ifndef REP_MIX
#define REP_MIX 1
#endif
#define GRID_SYNC() do { XcdBarrier xb_; xb_.bar = ctl + 4096; xb_.x = (unsigned)__builtin_amdgcn_readfirstlane((int)xbar_x); xb_.st = (volatile LAS unsigned*)(ldsl + RING_BYTES + 2048); xcd_barrier(xb_); } while (0)

__device__ __forceinline__ unsigned f2bf(float f) { unsigned u = __builtin_bit_cast(unsigned, f); return (u + 0x7fffu + ((u >> 16) & 1u)) >> 16; }
__device__ __forceinline__ unsigned pk2(float lo, float hi) { return f2bf(lo) | (f2bf(hi) << 16); }
__device__ __forceinline__ void transpose_item(const float* W, int N, int srccol, const float* kscale, bf16_t* WT, int K, int dstrow, int k0, LAS float* scr, int lane) {
    f32x4 t[8];
#pragma unroll
    for (int i = 0; i < 8; ++i) t[i] = __builtin_nontemporal_load((const f32x4*)(W + (size_t)(k0 + 8 * i + (lane >> 3)) * N + srccol + 4 * (lane & 7)));
#pragma unroll
    for (int i = 0; i < 8; ++i) { const int kk = 8 * i + (lane >> 3); f32x4 v = t[i]; if (kscale) v = v * kscale[k0 + kk];
        LAS float* d = scr + kk * 33 + 4 * (lane & 7); d[0] = v[0]; d[1] = v[1]; d[2] = v[2]; d[3] = v[3]; }
    asm volatile("s_waitcnt lgkmcnt(0)" ::: "memory");
    const int c = lane & 7;
#pragma unroll
    for (int j = 0; j < 4; ++j) { const int n = (lane >> 3) + 8 * j; const LAS float* s = scr + (8 * c) * 33 + n;
        u32x4 o; o.x = pk2(s[0 * 33], s[1 * 33]); o.y = pk2(s[2 * 33], s[3 * 33]); o.z = pk2(s[4 * 33], s[5 * 33]); o.w = pk2(s[6 * 33], s[7 * 33]);
        *(u32x4*)(WT + (size_t)(dstrow + n) * K + k0 + 8 * c) = o; }
    asm volatile("s_waitcnt lgkmcnt(0)" ::: "memory");
}
__device__ __forceinline__ int win_srccol(int gd) {
    if (gd < 16) { const int pn = gd >> 3, j = gd & 7, bj = j >> 2, wc = j & 3, head = 4 * pn + wc; return (head < 6 ? 1664 + 64 * head : 2048 + 64 * (head - 6)) + 32 * bj; }
    if (gd < 32) return 1152 + 32 * (gd - 16);
    if (gd < 44) return 32 * (gd - 32);
    if (gd < 56) return 384 + 32 * (gd - 44);
    if (gd < 68) return 768 + 32 * (gd - 56);
    return 2176 + 32 * (gd - 68);
}

constexpr int CV_IN = 16 * 72, CV_O = 16 * 32, CV_F1 = 16 * 176, CV_F2 = 44 * 32, CV_L = CV_IN + CV_O + CV_F1 + CV_F2;
__device__ __forceinline__ void conv_item(const Params& P, int l, int r, LAS float* scr, int lane) {
    unsigned char* wsb = P.ws;
    bf16_t* Win_ = (bf16_t*)(wsb + WS_WIN); bf16_t* Wo_ = (bf16_t*)(wsb + WS_WO); bf16_t* Wf1_ = (bf16_t*)(wsb + WS_WF1); bf16_t* Wf2_ = (bf16_t*)(wsb + WS_WF2);
    if (r < CV_IN) { const int kb = r / 72, gd = r % 72; transpose_item(P.w_in + (size_t)l * DM * DIN, DIN, win_srccol(gd), nullptr, Win_ + (size_t)l * DIN * DM, DM, 32 * gd, 64 * kb, scr, lane); return; } r -= CV_IN;
    if (r < CV_O) { const int kb = r / 32, gd = r % 32; transpose_item(P.w_o + (size_t)l * DM * DM, DM, 32 * gd, P.g_out + l * DM, Wo_ + (size_t)l * DM * DM, DM, 32 * gd, 64 * kb, scr, lane); return; } r -= CV_O;
    if (r < CV_F1) { const int kb = r / 176, gd = r % 176; const int pn = gd >> 3, j = gd & 7, bj = j >> 2, wc = j & 3;
        transpose_item(P.w_ffn_in + (size_t)l * DM * 2 * DFF, 2 * DFF, bj * DFF + 128 * pn + 32 * wc, nullptr, Wf1_ + (size_t)l * 2 * DFF * DM, DM, 32 * gd, 64 * kb, scr, lane); return; } r -= CV_F1;
    { const int kb = r / 32, gd = r % 32; transpose_item(P.w_ffn_out + (size_t)l * DFF * DM, DM, 32 * gd, nullptr, Wf2_ + (size_t)l * DM * DFF, DFF, 32 * gd, 64 * kb, scr, lane); }
}

__device__ __forceinline__ void wave_sum2(float& a, float& b) {
#pragma unroll
    for (int o = 1; o < 64; o <<= 1) { const float ta = __shfl_xor(a, o), tb = __shfl_xor(b, o); a += ta; b += tb; }
}
__device__ __forceinline__ void row_pass(const Params& P, int l, int mode, LAS float* pl) {
    const int tid_ = opaque_tid(), lane = tid_ & 63; const int NGW = gridDim.x * NWAVES, gw = blockIdx.x * NWAVES + __builtin_amdgcn_readfirstlane(tid_ >> 6);
    unsigned char* ws = P.ws;
    float* xres = (float*)(ws + WS_XRES); const bf16_t* Y = (const bf16_t*)(ws + WS_Y); bf16_t* H = (bf16_t*)(ws + WS_H);
    const float* mod = (const float*)(ws + WS_MOD); float* ssb = (float*)(ws + WS_SS); const float* y32 = (const float*)(ws + WS_Y32);
    const bool lastl = (l == DEPTH - 1);
    const bool latent_only = lastl && mode != 0;
    const int nrows = latent_only ? BATCH * SEQ : MROWS;
    const int gidx = (mode == 1) ? 2 : 5;
    const int ml = (mode == 2) ? l + 1 : l;
    const int shi = (mode == 1) ? 3 : 0;
    const bool make_h = !(lastl && mode == 2);
    const bool from_in = (mode == 0) || (mode == 1 && l == 0);
    const float* lg = (mode == 1) ? P.ln1_g + l * DM : P.ln2_g + l * DM;
    const float* lb = (mode == 1) ? P.ln1_b + l * DM : P.ln2_b + l * DM;
    { const int t_ = opaque_tid();
      for (int i = t_; i < 3 * DM; i += NTHREADS) { const int mvi = i >> 10, c = i & 1023;
          if (mode != 0) pl[i] = mod[(size_t)(l * 3 + mvi) * NMOD + gidx * DM + c];
          if (make_h) { pl[5120 + i] = mod[(size_t)(ml * 3 + mvi) * NMOD + shi * DM + c]; pl[8192 + i] = mod[(size_t)(ml * 3 + mvi) * NMOD + (shi + 1) * DM + c] + 1.0f; } }
      if (mode != 0) for (int i = t_; i < DM; i += NTHREADS) { pl[3072 + i] = lg[i]; pl[4096 + i] = lb[i]; }
      asm volatile("s_waitcnt lgkmcnt(0)" ::: "memory"); __syncthreads(); }
    f32x4 nx[2][4]; u32x2 ny[2][4];
#define RP_ISSUE(kq) do { _Pragma("unroll") for (int r = 0; r < 2; ++r) { \
        const int i_ = (kq) + r * NGW; const int ii_ = (i_ < nrows) ? i_ : (kq); \
        int b_, w_; if (latent_only) { b_ = ii_ / SEQ; w_ = ii_ % SEQ; } else { const int ir_ = (ii_ + 1536) % MROWS; b_ = ir_ / RPB; w_ = ir_ % RPB; } \
        const bool lat_ = w_ < SEQ; const int row_ = b_ * RPB + w_; \
        const float* src_ = from_in ? (lat_ ? P.x + ((size_t)b_ * SEQ + w_) * DM : P.ctx + ((size_t)b_ * CTXL + (w_ - SEQ)) * DM) : xres + (size_t)row_ * DM; \
        _Pragma("unroll") for (int j = 0; j < 4; ++j) nx[r][j] = __builtin_nontemporal_load((const f32x4*)(src_ + 4 * lane + 256 * j)); \
        if (mode != 0 && lat_) { _Pragma("unroll") for (int j = 0; j < 4; ++j) ny[r][j] = __builtin_nontemporal_load((const u32x2*)(Y + (size_t)row_ * DM + 4 * lane + 256 * j)); } } } while (0)
    if (gw < nrows) RP_ISSUE(gw);
    for (int i0 = gw; i0 < nrows; i0 += 2 * NGW) {
        f32x4 v[2][4], yv[2][4]; u32x2 yr[2][4]; int row[2], mv[2]; bool ok[2]; float* dst[2];
#pragma unroll
        for (int r = 0; r < 2; ++r)
#pragma unroll
            for (int j = 0; j < 4; ++j) { v[r][j] = nx[r][j]; yr[r][j] = ny[r][j]; }
        if (i0 + 2 * NGW < nrows) RP_ISSUE(i0 + 2 * NGW);
        __builtin_amdgcn_sched_barrier(0);
#pragma unroll
        for (int r = 0; r < 2; ++r) {
            const int i = i0 + r * NGW; ok[r] = i < nrows; const int ii = ok[r] ? i : i0;
            int b, w; if (latent_only) { b = ii / SEQ; w = ii % SEQ; } else { const int ir = (ii + 1536) % MROWS; b = ir / RPB; w = ir % RPB; }
            row[r] = b * RPB + w; const bool lat = w < SEQ; mv[r] = lat ? b : 2;
            dst[r] = (lastl && mode == 2) ? P.out + (size_t)ii * DM : xres + (size_t)row[r] * DM;
            if (mode != 0) {
                if (lat) {
#pragma unroll
                    for (int j = 0; j < 4; ++j) { const u32x2 yy = yr[r][j];
                        yv[r][j][0] = __uint_as_float(yy.x << 16); yv[r][j][1] = __uint_as_float(yy.x & 0xffff0000u); yv[r][j][2] = __uint_as_float(yy.y << 16); yv[r][j][3] = __uint_as_float(yy.y & 0xffff0000u); }
                } else {
                    const int nsl = (mode == 1) ? 3 : 11;
#pragma unroll
                    for (int j = 0; j < 4; ++j) { const float* yq = y32 + (size_t)(b * CTXL + (w - SEQ)) * DM + 4 * lane + 256 * j; f32x4 a = *(const f32x4*)yq;
                        for (int sl = 1; sl < nsl; ++sl) a = a + *(const f32x4*)(yq + (size_t)sl * 512 * DM);
                        yv[r][j] = a; }
                }
            }
        }
        if (mode != 0) {
            float s[2], q[2];
#pragma unroll
            for (int r = 0; r < 2; ++r) { const LAS float* gm = pl + mv[r] * DM; s[r] = 0.f; q[r] = 0.f;
#pragma unroll
                for (int j = 0; j < 4; ++j) { const f32x4 g = *(const LAS f32x4*)(gm + 4 * lane + 256 * j); v[r][j] = v[r][j] * ALPHA + g * yv[r][j];
                    s[r] += (v[r][j][0] + v[r][j][1]) + (v[r][j][2] + v[r][j][3]); const f32x4 sq = v[r][j] * v[r][j]; q[r] += (sq[0] + sq[1]) + (sq[2] + sq[3]); } }
            wave_sum2(s[0], s[1]); wave_sum2(q[0], q[1]);
#pragma unroll
            for (int r = 0; r < 2; ++r) { const float mean = s[r] * (1.f / DM); const float var = fmaxf(q[r] * (1.f / DM) - mean * mean, 0.f); const float rstd = 1.f / sqrtf(var + LN_EPS);
#pragma unroll
                for (int j = 0; j < 4; ++j) { const f32x4 g = *(const LAS f32x4*)(pl + 3072 + 4 * lane + 256 * j), bb = *(const LAS f32x4*)(pl + 4096 + 4 * lane + 256 * j); v[r][j] = (v[r][j] - mean) * rstd * g + bb; } }
        }
        if (mode != 0) {
#pragma unroll
        for (int r = 0; r < 2; ++r) if (ok[r]) {
#pragma unroll
            for (int j = 0; j < 4; ++j) __builtin_nontemporal_store(v[r][j], (f32x4*)(dst[r] + 4 * lane + 256 * j)); } }
        if (make_h) {
            float s[2], q[2];
#pragma unroll
            for (int r = 0; r < 2; ++r) { s[r] = 0.f; q[r] = 0.f;
#pragma unroll
                for (int j = 0; j < 4; ++j) { s[r] += (v[r][j][0] + v[r][j][1]) + (v[r][j][2] + v[r][j][3]); const f32x4 sq = v[r][j] * v[r][j]; q[r] += (sq[0] + sq[1]) + (sq[2] + sq[3]); } }
            wave_sum2(s[0], s[1]); wave_sum2(q[0], q[1]);
#pragma unroll
            for (int r = 0; r < 2; ++r) if (ok[r]) { const float mean = s[r] * (1.f / DM); const float var = fmaxf(q[r] * (1.f / DM) - mean * mean, 0.f); const float rstd = 1.f / sqrtf(var + LN_EPS);
                const LAS float* mm = pl + 5120 + mv[r] * DM;
#pragma unroll
                for (int j = 0; j < 4; ++j) { const f32x4 sh = *(const LAS f32x4*)(mm + 4 * lane + 256 * j), sc1 = *(const LAS f32x4*)(mm + 3072 + 4 * lane + 256 * j);
                    const f32x4 hv = (v[r][j] - mean) * rstd * sc1 + sh; u32x2 o; o.x = cvt_pk_bf16(hv[0], hv[1]); o.y = cvt_pk_bf16(hv[2], hv[3]);
                    *(u32x2*)(H + (size_t)row[r] * DM + 4 * lane + 256 * j) = o; } }
        }
        if (mode != 1 && lane == 0) {
#pragma unroll
            for (int r = 0; r < 2; ++r) if (ok[r]) { float z_; asm volatile("v_mov_b32 %0, 0" : "=v"(z_)); *(f32x4*)(ssb + (size_t)row[r] * 4) = (f32x4){z_, z_, z_, z_}; } }
    }
}

#undef RP_ISSUE
constexpr int SG_VT = 0, SG_VT_PITCH = 136, SG_STAGE = 73728;
__device__ __forceinline__ void sg_unit(const Params& P, int l, int chunk, char* shm, float* ssb) {
    const int tid_ = opaque_tid(), lane = tid_ & 63, wid = __builtin_amdgcn_readfirstlane(tid_ >> 6);
    unsigned char* ws = P.ws;
    const bf16_t* qkv = (const bf16_t*)(ws + WS_QKV); bf16_t* omix = (bf16_t*)(ws + WS_OMIX);
    const bf16_t* Wsb = (const bf16_t*)(ws + WS_WS) + (size_t)l * 4 * 128 * 128;
    const int R0 = chunk * 128;
    bf16_t* vt = (bf16_t*)(shm + SG_VT);
    const float* gs = P.g_sgu + l * 256;
    const f32x4 g4 = *(const f32x4*)(gs + 4 * lane);
    for (int q = wid * 16; q < wid * 16 + 16; ++q) {
        const u32x2 vv = *(const u32x2*)(qkv + (size_t)(R0 + q) * DIN + C_V + 4 * lane);
        f32x4 v; v[0] = __uint_as_float(vv.x << 16); v[1] = __uint_as_float(vv.x & 0xffff0000u); v[2] = __uint_as_float(vv.y << 16); v[3] = __uint_as_float(vv.y & 0xffff0000u);
        const float mean = wave_sum((v[0] + v[1]) + (v[2] + v[3])) * (1.f / 256.f);
        v = v - mean; const f32x4 sq = v * v;
        const float rstd = 1.f / sqrtf(wave_sum((sq[0] + sq[1]) + (sq[2] + sq[3])) * (1.f / 256.f) + LN_EPS);
        v = v * rstd * g4;
#pragma unroll
        for (int j = 0; j < 4; ++j) vt[(4 * lane + j) * SG_VT_PITCH + q] = (bf16_t)(at::cvtpk_s(v[j], 0.f) & 0xffffu);
    }
    asm volatile("s_waitcnt lgkmcnt(0)\n\ts_barrier" ::: "memory");
    const int g = wid >> 1, ph = wid & 1, r32 = lane & 31, hi = lane >> 5;
    f32x16 acc[2][2];
#pragma unroll
    for (int a = 0; a < 2; ++a)
#pragma unroll
        for (int b = 0; b < 2; ++b) acc[a][b] = f32x16{};
    const bf16_t* Wg = Wsb + (size_t)g * 128 * 128;
#pragma unroll
    for (int k0 = 0; k0 < 128; k0 += 16) {
        bf16x8 af[2], bfr[2];
#pragma unroll
        for (int pt = 0; pt < 2; ++pt) af[pt] = *(const bf16x8*)(Wg + (size_t)(64 * ph + 32 * pt + r32) * 128 + k0 + 8 * hi);
#pragma unroll
        for (int ct = 0; ct < 2; ++ct) bfr[ct] = *(const bf16x8*)(vt + (64 * g + 32 * ct + r32) * SG_VT_PITCH + k0 + 8 * hi);
#pragma unroll
        for (int pt = 0; pt < 2; ++pt)
#pragma unroll
            for (int ct = 0; ct < 2; ++ct) acc[pt][ct] = __builtin_amdgcn_mfma_f32_32x32x16_bf16(af[pt], bfr[ct], acc[pt][ct], 0, 0, 0);
    }
    const float* bs = P.b_s + (size_t)l * 512 + g * 128;
    float ones[16];
#pragma unroll
    for (int r = 0; r < 16; ++r) ones[r] = 1.0f;
#pragma unroll
    for (int pt = 0; pt < 2; ++pt) {
        f32x16 o[2];
#pragma unroll
        for (int r = 0; r < 16; ++r) { const int p = 64 * ph + 32 * pt + at::crow(r, hi); const float bp = bs[p];
#pragma unroll
            for (int ct = 0; ct < 2; ++ct) { const float uu = bf2f(qkv[(size_t)(R0 + p) * DIN + C_U + 64 * g + 32 * ct + r32]); o[ct][r] = uu * (acc[pt][ct][r] + bp); } }
        const int prow = R0 + 64 * ph + 32 * pt;
        at::store_tile(o, ones, (bf16_t*)(shm + SG_STAGE) + wid * 2048, omix + (size_t)prow * DM + 384 + 64 * g, DM, ssb + (size_t)prow * 4 + 1, lane, r32, hi);
    }
    asm volatile("s_waitcnt vmcnt(0) lgkmcnt(0)\n\ts_barrier" ::: "memory");
}

__global__ void __launch_bounds__(NTHREADS, 2) mega_fwd(Params P) {
    extern __shared__ __attribute__((aligned(16))) unsigned char lds[];
    cg::grid_group grid = cg::this_grid();
    LAS unsigned char* ldsl = (LAS unsigned char*)lds;
    const int G = gridDim.x, bx = blockIdx.x;
#define ws (opq(P.ws))
#define ctl ((unsigned*)(ws + WS_CTL))
#define mod ((float*)(ws + WS_MOD))
#define tcos ((float*)(ws + WS_ROPE))
#define tsin ((float*)(ws + WS_ROPE) + 128 * 16)
#define Win ((bf16_t*)(ws + WS_WIN))
#define Wo ((bf16_t*)(ws + WS_WO))
#define Wf1 ((bf16_t*)(ws + WS_WF1))
#define Wf2 ((bf16_t*)(ws + WS_WF2))
#define Hb ((bf16_t*)(ws + WS_H))
#define Yb ((bf16_t*)(ws + WS_Y))
#define qkv ((bf16_t*)(ws + WS_QKV))
#define omix ((bf16_t*)(ws + WS_OMIX))
#define hid ((bf16_t*)(ws + WS_HID))
#define ssb ((float*)(ws + WS_SS))
    { volatile LAS unsigned* st0 = (volatile LAS unsigned*)(ldsl + RING_BYTES + 2048); if (threadIdx.x < 2) st0[threadIdx.x] = 0u; __syncthreads(); }
    const unsigned xbar_x = xcd_barrier_post(ctl + 4096, (volatile LAS unsigned*)(ldsl + RING_BYTES + 2048)).x;

    if (PH & 1) {
        const int tid = opaque_tid(), lane = tid & 63, wid = __builtin_amdgcn_readfirstlane(tid >> 6);
        const int gw = bx * NWAVES + wid, NGW = G * NWAVES;
        LAS float* scv = (LAS float*)(ldsl + 69632);
        LAS float* red = (LAS float*)(ldsl + 69632 + 12288);
        for (int i = tid; i < 3 * DM; i += NTHREADS) { const int v = i / DM, k = i % DM; const float cv = (v < 2) ? P.c[v * DM + k] : P.c_ctx[k]; scv[i] = cv / (1.0f + __expf(-cv)); }
        __syncthreads();
        if (bx == 0 && wid == 0) { for (int l2 = 0; l2 < DEPTH; ++l2) { float a = fabsf(P.g_q[l2 * 64 + lane]), c2 = fabsf(P.g_k[l2 * 64 + lane]);
#pragma unroll
                for (int o_ = 1; o_ < 64; o_ <<= 1) { a = fmaxf(a, __shfl_xor(a, o_)); c2 = fmaxf(c2, __shfl_xor(c2, o_)); }
                if (lane == 0) tcos[4096 + l2] = fminf(8.0f * LOG2E * 1.02f * a * c2, 60.0f); } }
        for (int i = bx * NTHREADS + tid; i < 128 * 16; i += G * NTHREADS) { const int pos = i >> 4, f = i & 15;
            const float inv = exp2f(-(float)f * (13.287712379549449f / 16.0f)); const float ang = (float)pos * inv;
            tcos[i] = cosf(ang); tsin[i] = sinf(ang); }
        { bf16_t* Wsb = (bf16_t*)(ws + WS_WS); for (int i = bx * NTHREADS + tid; i < DEPTH * 4 * 128 * 128; i += G * NTHREADS) Wsb[i] = (bf16_t)f2bf(P.w_s[i]); }
        LAS float* scr = (LAS float*)(ldsl + wid * 8448);
        LAS int* qslot = (LAS int*)(ldsl + RING_BYTES + 1024);
        for (;;) {
            if (tid == 0) qslot[0] = (int)atomicAdd(ctl + 64 * 20, 1u);
            __syncthreads();
            const int qi = __builtin_amdgcn_readfirstlane(qslot[0]);
            __syncthreads();
            if (qi >= DEPTH * 24 + CV_L / 8) break;
            if (qi < DEPTH * 24) {
                const int l2 = qi / 24, cg4 = qi % 24, n4 = 256 * cg4 + 4 * lane;
                const float* W = P.w_mod + (size_t)l2 * DM * NMOD + n4;
                f32x4 a0 = {0.f, 0.f, 0.f, 0.f}, a1 = a0, a2 = a0;
#pragma unroll 16
                for (int kk = 0; kk < 128; ++kk) { const int k = wid * 128 + kk; const f32x4 wv = __builtin_nontemporal_load((const f32x4*)(W + (size_t)k * NMOD)); a0 += wv * scv[k]; a1 += wv * scv[DM + k]; a2 += wv * scv[2 * DM + k]; }
                LAS f32x4* red4 = (LAS f32x4*)red;
                red4[(wid * 3 + 0) * 64 + lane] = a0; red4[(wid * 3 + 1) * 64 + lane] = a1; red4[(wid * 3 + 2) * 64 + lane] = a2;
                __syncthreads();
                for (int o = tid; o < 768; o += NTHREADS) { const int v = o >> 8, col = o & 255; float sacc = P.b_mod[(size_t)l2 * NMOD + 256 * cg4 + col];
#pragma unroll
                    for (int w2 = 0; w2 < 8; ++w2) sacc += red[(w2 * 3 + v) * 256 + col];
                    mod[(size_t)(l2 * 3 + v) * NMOD + 256 * cg4 + col] = sacc; }
                __syncthreads();
            } else {
                conv_item(P, 0, (qi - DEPTH * 24) * 8 + wid, scr, lane);
            }
        }
    }
    if (G == 0x7fffffff) grid.sync();
    GRID_SYNC();
    if (PH & 2) row_pass(P, 0, 0, (LAS float*)ldsl);
    GRID_SYNC();

    for (int l = 0; l < DEPTH; ++l) {
        const bool lastl = (l == DEPTH - 1);
        if (PH & 4) { pg8::Gemm g{Hb, Win + (size_t)l * DIN * DM, MROWS, DIN, DM}; pg8::StaticOrder S; S.init(66, DIN, G, bx, 0, 16, 4);
          pg8::EpiQKV E{qkv, P.g_q + l * 64, P.g_k + l * 64, tcos, tsin};
          pg8::gemm_phase<pg8::EpiQKV, pg8::StaticOrder, true, true>(ldsl, g, S, E); }
        if (!lastl && bx >= 82) {
            const int t_ = opaque_tid(), w_ = __builtin_amdgcn_readfirstlane(t_ >> 6);
            for (int c = bx - 82; c < CV_L / 8; c += G - 82) conv_item(P, l + 1, c * 8 + w_, (LAS float*)(ldsl + w_ * 8448), t_ & 63);
        }
        GRID_SYNC();
        {
            LAS int* qslot = (LAS int*)(ldsl + RING_BYTES + 1024);
            const int n_gqa = 384, n_na = 384, n_sg = 132, n_cx = lastl ? 0 : 24;
            const int n_prod = n_gqa + n_na + n_sg + n_cx;
            const int ntot = n_prod + 256 + (lastl ? 0 : 24);
            unsigned* cw = ctl + CW_DEP + (size_t)l * 66 * 16;
            for (;;) {
                if (opaque_tid() == 0) qslot[0] = (int)atomicAdd(ctl + 64 * (l + 1), 1u);
                __syncthreads();
                const int idx = __builtin_amdgcn_readfirstlane(qslot[0]);
                __syncthreads();
                if (idx >= ntot) break;
                if (idx < n_gqa) {
                    const int qb = idx / 12, r12 = idx % 12, b = r12 / 6, h = r12 % 6; const size_t rb = (size_t)b * RPB;
                    ap::unit<8, 0>(qkv + (rb + 256 * qb) * DIN + C_QC + 64 * h, qkv + rb * DIN + C_KC + 64 * (h / 3), qkv + rb * DIN + C_VC + 64 * (h / 3),
                                   omix + (rb + 256 * qb) * DM + 640 + 64 * h, ssb + (rb + 256 * qb) * 4 + 2, 132, (char*)lds, 0, 0, tcos[4096 + l]);
                    publish_cnt(cw + (b * 33 + qb) * 16);
                } else if (idx < n_gqa + n_na) {
                    const int i2 = idx - n_gqa; const int rblk = i2 / 12, r12 = i2 % 12, b = r12 / 6, h = r12 % 6; const size_t rb = (size_t)b * RPB;
                    { float* bl = (float*)((char*)lds + ap::LDS_NABIAS); const float* src = P.rpb + ((size_t)l * 6 + h) * 465; for (int i = opaque_tid(); i < 465; i += NTHREADS) bl[i] = src[i] * LOG2E; }
                    __syncthreads();
                    const int r0 = 4 * rblk, klo = min(max(r0 - 4, 0), 120), khi = min(max(r0 - 1, 0), 120) + 7; const int nlt = (khi - klo + 2) & ~1;
                    ap::unit<8, 1>(qkv + (rb + 256 * rblk) * DIN + C_QA + 64 * h, qkv + rb * DIN + C_KA + 64 * h, qkv + rb * DIN + C_VA + 64 * h,
                                   omix + (rb + 256 * rblk) * DM + 64 * h, ssb + (rb + 256 * rblk) * 4 + 0, 4 + nlt, (char*)lds, klo, r0);
                    publish_cnt(cw + (b * 33 + rblk) * 16);
                } else if (idx < n_gqa + n_na + n_sg) {
                    const int ch = idx - n_gqa - n_na;
                    if (!(lastl && (ch % 66) >= 64)) { sg_unit(P, l, ch, (char*)lds, ssb); publish_cnt(cw + (ch >> 1) * 16); }
                } else if (idx < n_prod) {
                    const int i2 = idx - n_gqa - n_na - n_sg; const bool isna = i2 < 12; const int i3 = isna ? i2 : i2 - 12; const int b = i3 / 6, h = i3 % 6; const size_t rb = (size_t)b * RPB + SEQ;
                    at::Job J; J.Q = qkv + rb * DIN + (isna ? C_QA : C_QC) + 64 * h;
                    J.Kc = qkv + rb * DIN + (isna ? C_KA + 64 * h : C_KC + 64 * (h / 3)); J.Vc = qkv + rb * DIN + (isna ? C_VA + 64 * h : C_VC + 64 * (h / 3));
                    J.Kl = J.Kc; J.Vl = J.Vc; J.O = omix + rb * DM + (isna ? 0 : 640) + 64 * h; J.ss = ssb + rb * 4 + (isna ? 0 : 2); J.nctx = 4; J.lt0 = 0; J.nlt = 0; J.r0 = 0;
                    at::unit<0>(J, (char*)lds);
                    publish_cnt(cw + (b * 33 + 32) * 16);
                } else {
                    const int j = idx - n_prod; OneUnit S1;
                    if (j < 256) { S1.u.pm = ((j >> 2) & 1) * 33 + (j >> 3); S1.u.pn = j & 3; S1.u.kt0 = 0; S1.u.nt = 16; }
                    else { const int jj = j - 256, tile = jj / 3, sl = jj % 3; S1.u.pm = (tile >> 2) ? 65 : 32; S1.u.pn = tile & 3; S1.u.kt0 = (sl == 0) ? 0 : (sl == 1 ? 6 : 10); S1.u.nt = (sl == 1) ? 4 : 6; }
                    wait_cnt(cw + S1.u.pm * 16, 14u);
                    LAS float* ft = (LAS float*)(ldsl + RING_BYTES + 4096);
                    if (j < 256) { const int t_ = opaque_tid(); if (t_ < 256) { const f32x4 s4 = *(const f32x4*)(ssb + (size_t)(S1.u.pm * 256 + t_) * 4);
                            const float ra = 1.0f / sqrtf(s4[0] * (1.0f / 384.0f) + LN_EPS), rb = 1.0f / sqrtf(s4[1] * (1.0f / 256.0f) + LN_EPS), rc = 1.0f / sqrtf(s4[2] * (1.0f / 384.0f) + LN_EPS);
                            ft[t_ * 4 + 0] = ra / rb; ft[t_ * 4 + 1] = rb / rc; ft[t_ * 4 + 2] = rc; }
                        __syncthreads(); }
                    pg8::Gemm g{omix, Wo + (size_t)l * DM * DM, MROWS, DM, DM};
                    pg8::EpiY<true> E{Yb, ssb, (float*)(ws + WS_Y32), 16, (j < 256) ? (const LAS float*)ft : (const LAS float*)nullptr};
                    pg8::gemm_phase<pg8::EpiY<true>, OneUnit, false, true>(ldsl, g, S1, E);
                }
            }
        }
        GRID_SYNC();
        if (PH & 2) row_pass(P, l, 1, (LAS float*)ldsl);
        GRID_SYNC();
        if (PH & 32) { pg8::Gemm g{Hb, Wf1 + (size_t)l * 2 * DFF * DM, MROWS, 2 * DFF, DM}; pg8::StaticOrder S; S.init(lastl ? 64 : 66, 2 * DFF, G, bx, lastl ? 1 : 0, 16);
          pg8::EpiSwiGLU E{hid};
          pg8::gemm_phase<pg8::EpiSwiGLU, pg8::StaticOrder, true, true>(ldsl, g, S, E); }
        GRID_SYNC();
        if (PH & 64) { pg8::Gemm g{hid, Wf2 + (size_t)l * DM * DFF, MROWS, DM, DFF}; pg8::StaticOrder S; S.init(64, DM, G, bx, 1, 44, lastl ? 0 : 2);
          pg8::EpiY<false> E{Yb, nullptr, (float*)(ws + WS_Y32), 44};
          pg8::gemm_phase<pg8::EpiY<false>, pg8::StaticOrder, true, true>(ldsl, g, S, E); }
        GRID_SYNC();
        if (PH & 2) row_pass(P, l, 2, (LAS float*)ldsl);
        if (!lastl) GRID_SYNC();
    }
}

#undef ws
#undef ctl
#undef mod
#undef tcos
#undef tsin
#undef Win
#undef Wo
#undef Wf1
#undef Wf2
#undef Hb
#undef Yb
#undef qkv
#undef omix
#undef hid
#undef ssb
extern "C" void kernel_launch(void* const* d_in, const int* in_sizes, int n_in, void* d_out, int out_size, void* d_ws, size_t ws_size, hipStream_t stream) {
    static int grid = 0;
    if (grid == 0) {
        if (n_in != 21 || ws_size < WS_TOTAL) { fprintf(stderr, "kernel_launch: need 21 inputs and %zu bytes of workspace; got %d, %zu\n", (size_t)WS_TOTAL, n_in, ws_size); grid = -1; return; }
        int dev = 0, cus = 0, per_cu = 0;
        hipGetDevice(&dev); hipDeviceGetAttribute(&cus, hipDeviceAttributeMultiprocessorCount, dev);
        if (hipFuncSetAttribute((const void*)mega_fwd, hipFuncAttributeMaxDynamicSharedMemorySize, LDS_BYTES) != hipSuccess) { fprintf(stderr, "kernel_launch: hipFuncSetAttribute failed\n"); grid = -1; return; }
        if (hipOccupancyMaxActiveBlocksPerMultiprocessor(&per_cu, (const void*)mega_fwd, NTHREADS, LDS_BYTES) != hipSuccess || per_cu < 1) { fprintf(stderr, "kernel_launch: occupancy query says %d\n", per_cu); per_cu = 1; }
        (void)hipGetLastError();
        grid = cus;
    }
    if (grid < 0) return;
    hipMemsetAsync((char*)d_ws + WS_CTL, 0, CTL_BYTES, stream);
    Params p{};
    const float** pp = (const float**)&p;
    for (int i = 0; i < 21; ++i) pp[i] = (const float*)d_in[i];
    p.out = (float*)d_out; p.ws = (unsigned char*)d_ws;
    void* args[] = {&p};
    hipError_t e = hipLaunchCooperativeKernel((const void*)mega_fwd, dim3(grid), dim3(NTHREADS), args, LDS_BYTES, stream);
    if (e != hipSuccess) fprintf(stderr, "cooperative launch failed: %s (grid %d)\n", hipGetErrorString(e), grid);
}
```
